# Optimizing an MI355X kernel written in HIP

```python
import math
import jax, jax.numpy as jnp
from jax import lax
import numpy as np

D_MODEL = 1024
BATCH = 32
SEQ = 256
DEPTH = 4
DEC_BATCH = 2
DEC_SEQ = 4096
PAST_LEN = 256

GRID_W = 64
D_MIX = D_MODEL
D_GROUP = D_MIX // 4
HEAD_DIM = 64
H_A = D_GROUP // HEAD_DIM
H_D = D_GROUP // HEAD_DIM
N_DIR = 2
RANK_W = 64
RANK_A = 64
RANK_G = 128
POOL_WINDOWS = (2, 4, 8, 16)
N_POOL = len(POOL_WINDOWS)
POOL_CH = D_GROUP // N_POOL
CONV_W = 31
QK_CONV_W = 3
MLSTM_CHUNK = 64
D_FF = 4 * D_MODEL
EPS = 1e-6
RWKV_LN_EPS = 64e-5
CONV_LN_EPS = 1e-5

A_W = 3 * D_GROUP + RANK_W + RANK_A + RANK_G
B_W = D_GROUP
C_W = 2 * D_GROUP
D_W = 4 * D_GROUP + 2 * N_DIR * H_D
D_IN = A_W + B_W + C_W + D_W
IN_SPLITS = [A_W, A_W + B_W, A_W + B_W + C_W]
A_SPLITS = [D_GROUP, 2 * D_GROUP, 3 * D_GROUP, 3 * D_GROUP + RANK_W, 3 * D_GROUP + RANK_W + RANK_A]
D_SPLITS = [2 * D_GROUP, 3 * D_GROUP, 3 * D_GROUP + N_DIR * H_D, 3 * D_GROUP + 2 * N_DIR * H_D]

kernel_name = 'hybrid_rwkv7_pool_conformer_mlstm_dit_step'

F32 = jnp.float32


def rms_norm(x, g):
    xf = x.astype(F32)
    y = xf * lax.rsqrt(jnp.mean(xf * xf, axis=-1, keepdims=True) + EPS)
    return (y * g).astype(x.dtype)


def layer_norm(x, g, b, eps):
    xf = x.astype(F32)
    mu = jnp.mean(xf, axis=-1, keepdims=True)
    var = jnp.mean(jnp.square(xf - mu), axis=-1, keepdims=True)
    return ((xf - mu) * lax.rsqrt(var + eps) * g + b).astype(x.dtype)


def dwconv(x, w):
    k, ch = w.shape
    return lax.conv_general_dilated(x, w[:, None, :], window_strides=(1,), padding=[(k // 2, k // 2)],
                                    dimension_numbers=('NWC', 'WIO', 'NWC'), feature_group_count=ch)


def token_shift(x):
    zero = jnp.zeros_like(x[:, :1])
    prev = jnp.concatenate([zero, x[:, :-1]], axis=1)
    nxt = jnp.concatenate([x[:, 1:], zero], axis=1)
    return 0.5 * (prev + nxt)


def window_bounds(n, win):
    t = np.arange(n)
    return np.clip(t - win // 2, 0, n), np.clip(t + win // 2, 0, n)


def pool_seq(x, win):
    b, t, ch = x.shape
    cs = jnp.concatenate([jnp.zeros((b, 1, ch), x.dtype), jnp.cumsum(x, axis=1)], axis=1)
    lo, hi = window_bounds(t, win)
    cnt = (hi - lo).astype(np.float32)
    return (cs[:, hi] - cs[:, lo]) / cnt[None, :, None]


def pool_grid(x, win):
    b, t, ch = x.shape
    rows = t // GRID_W
    g = x.reshape(b, rows, GRID_W, ch)
    sat = jnp.pad(jnp.cumsum(jnp.cumsum(g, axis=1), axis=2), ((0, 0), (1, 0), (1, 0), (0, 0)))
    r_lo, r_hi = window_bounds(rows, win)
    c_lo, c_hi = window_bounds(GRID_W, win)
    band = sat[:, r_hi] - sat[:, r_lo]
    box = band[:, :, c_hi] - band[:, :, c_lo]
    cnt = np.outer(r_hi - r_lo, c_hi - c_lo).astype(np.float32)
    return (box / cnt[None, :, :, None]).reshape(b, t, ch)


def rwkv_scan(r, w, k, v, kk, a, s0, reverse):
    def step(s, inp):
        r_t, w_t, k_t, v_t, kk_t, a_t = inp
        sk = jnp.einsum('bhvk,bhk->bhv', s, kk_t)
        s = (s * w_t[:, :, None, :] - sk[..., None] * (kk_t * a_t)[:, :, None, :]
             + v_t[..., None] * k_t[:, :, None, :])
        return s, jnp.einsum('bhvk,bhk->bhv', s, r_t)
    xs = tuple(jnp.moveaxis(z, 1, 0) for z in (r, w, k, v, kk, a))
    s_final, y = lax.scan(step, s0, xs, reverse=reverse)
    return jnp.moveaxis(y, 0, 1), s_final


def rwkv_mix(z, s0, P, l):
    dt = z.dtype
    z = z + (token_shift(z) - z) * P['rwkv_mu'][l]
    r, k, v, wd, ad, gd = jnp.split(z, A_SPLITS, axis=-1)
    b, t, _ = r.shape
    hd = lambda u: u.astype(F32).reshape(b, t, H_A, HEAD_DIM)
    kk = hd(k * P['rwkv_k_k'][l])
    kk = kk * lax.rsqrt(jnp.sum(kk * kk, axis=-1, keepdims=True) + 1e-12)
    rh, vh = hd(r), hd(v)
    wt = jnp.tanh(wd)
    g = jax.nn.sigmoid(gd) @ P['rwkv_g_up'][l]
    ys, finals = [], []
    for d in range(N_DIR):
        w_log = -jax.nn.softplus(-(P['rwkv_w0'][l, d] + wt @ P['rwkv_w_up'][l, d])) - 0.5
        decay = jnp.exp(-jnp.exp(w_log.astype(F32)))
        a = jax.nn.sigmoid(P['rwkv_a0'][l, d] + ad @ P['rwkv_a_up'][l, d])
        kd = hd(k * (1.0 + (a - 1.0) * P['rwkv_k_a'][l]))
        yd, sd = rwkv_scan(rh, hd(decay), kd, vh, kk, hd(a), s0[:, d].astype(F32), reverse=(d == 1))
        bonus = jnp.sum(rh * kd * P['rwkv_r_k'][l], axis=-1, keepdims=True) * vh
        ys.append(yd + bonus)
        finals.append(sd)
    y = layer_norm(ys[0] + ys[1], P['rwkv_ln_g'][l].reshape(H_A, HEAD_DIM),
                   P['rwkv_ln_b'][l].reshape(H_A, HEAD_DIM), RWKV_LN_EPS)
    return (y.reshape(b, t, D_GROUP) * g).astype(dt), jnp.stack(finals, axis=1)


def pool_mix(z, P, l, grid):
    zf = z.astype(F32)
    outs = []
    for gi, win in enumerate(POOL_WINDOWS):
        zg = zf[..., gi * POOL_CH:(gi + 1) * POOL_CH]
        pooled = pool_grid(zg, win) if grid else pool_seq(zg, win)
        outs.append((pooled - zg).astype(z.dtype) @ P['pool_w'][l, gi])
    return jnp.concatenate(outs, axis=-1) * P['pool_scale'][l]


def conv_mix(z, P, l):
    val, gate = jnp.split(z, 2, axis=-1)
    u = val * jax.nn.sigmoid(gate)
    u = dwconv(u, P['conv_dw'][l]) + P['conv_b'][l]
    u = jax.nn.silu(layer_norm(u, P['conv_ln_g'][l], P['conv_ln_b'][l], CONV_LN_EPS))
    return u @ P['conv_pw'][l]


def mlstm_chunkwise(q, k, v, logi, logf, c0, n0, m0):
    b, t, h, dh = q.shape
    L = MLSTM_CHUNK
    nc = t // L
    chunks = lambda z: jnp.moveaxis(z.reshape((b, nc, L) + z.shape[2:]), 1, 0)
    causal = jnp.tril(jnp.ones((L, L), dtype=bool))[None, :, :, None]

    def step(carry, inp):
        c, n, m = carry
        qc, kc, vc, li, lf = inp
        bcum = jnp.cumsum(lf, axis=1)
        log_w = jnp.where(causal, bcum[:, :, None] - bcum[:, None] + li[:, None], -jnp.inf)
        m_t = jnp.maximum(bcum + m[:, None], jnp.max(log_w, axis=2))
        w = jnp.exp(log_w - m_t[:, :, None])
        inter = jnp.exp(bcum + m[:, None] - m_t)
        s = jnp.einsum('bthd,bshd->btsh', qc, kc) * w
        num = jnp.einsum('btsh,bshd->bthd', s, vc) + inter[..., None] * jnp.einsum('bhvk,bthk->bthv', c, qc)
        den = jnp.sum(s, axis=2) + inter * jnp.einsum('bhk,bthk->bth', n, qc)
        hc = num / jnp.maximum(jnp.abs(den), jnp.exp(-m_t))[..., None]
        m_new = m_t[:, -1]
        w_end = jnp.exp(bcum[:, -1:] - bcum + li - m_new[:, None])
        carry_decay = jnp.exp(bcum[:, -1] + m - m_new)
        c = carry_decay[..., None, None] * c + jnp.einsum('bsh,bshv,bshk->bhvk', w_end, vc, kc)
        n = carry_decay[..., None] * n + jnp.einsum('bsh,bshk->bhk', w_end, kc)
        return (c, n, m_new), hc

    (c, n, m), hs = lax.scan(step, (c0, n0, m0), tuple(chunks(z) for z in (q, k, v, logi, logf)))
    return jnp.moveaxis(hs, 0, 1).reshape(b, t, h, dh), (c, n, m)


def mlstm_mix(z, c0, n0, m0, P, l):
    dt = z.dtype
    qk, v, ipre, fpre, opre = jnp.split(z, D_SPLITS, axis=-1)
    qk = jax.nn.silu(dwconv(qk, P['mlstm_qk_conv'][l]))
    q, k = jnp.split(qk, 2, axis=-1)
    b, t, _ = q.shape
    hd = lambda u: u.astype(F32).reshape(b, t, H_D, HEAD_DIM)
    logi = (ipre + P['mlstm_i_bias'][l]).astype(F32).reshape(b, t, N_DIR, H_D)
    logf = jax.nn.log_sigmoid((fpre + P['mlstm_f_bias'][l]).astype(F32)).reshape(b, t, N_DIR, H_D)
    qh, kh, vh = hd(q), hd(k) * (1.0 / math.sqrt(HEAD_DIM)), hd(v)
    hs, cs, ns, ms = [], [], [], []
    for d in range(N_DIR):
        seqs = (qh, kh, vh, logi[:, :, d], logf[:, :, d])
        if d == 1:
            seqs = tuple(jnp.flip(u, axis=1) for u in seqs)
        hdir, (cd, nd, md) = mlstm_chunkwise(*seqs, c0[:, d].astype(F32), n0[:, d].astype(F32), m0[:, d].astype(F32))
        if d == 1:
            hdir = jnp.flip(hdir, axis=1)
        hs.append(hdir)
        cs.append(cd)
        ns.append(nd)
        ms.append(md)
    hsum = (hs[0] + hs[1]) * jax.nn.sigmoid(hd(opre))
    hsum = rms_norm(hsum, P['mlstm_hn_g'][l].reshape(H_D, HEAD_DIM)).reshape(b, t, D_GROUP)
    return hsum.astype(dt), (jnp.stack(cs, axis=1), jnp.stack(ns, axis=1), jnp.stack(ms, axis=1))


def trunk_layer(x, mod, P, l, states, grid):
    sh1, sc1, g1, sh2, sc2, g2 = jnp.split(mod[:, None, :], 6, axis=-1)
    h = rms_norm(x, P['norm1_g'][l]) * (1.0 + sc1) + sh1
    z = h @ P['w_in'][l]
    za, zb, zc, zd = jnp.split(z, IN_SPLITS, axis=-1)
    s_rwkv, s_c, s_n, s_m = states
    ya, f_rwkv = rwkv_mix(za, s_rwkv, P, l)
    yb = pool_mix(zb, P, l, grid)
    yc = conv_mix(zc, P, l)
    yd, (f_c, f_n, f_m) = mlstm_mix(zd, s_c, s_n, s_m, P, l)
    y = jnp.concatenate([ya, yb, yc, yd], axis=-1) @ P['w_out'][l]
    x = x + g1 * y
    h = rms_norm(x, P['norm2_g'][l]) * (1.0 + sc2) + sh2
    f = jnp.square(jax.nn.relu(h @ P['mlp_w1'][l] + P['mlp_b1'][l])) @ P['mlp_w2'][l] + P['mlp_b2'][l]
    x = x + g2 * f
    return x, (f_rwkv, f_c, f_n, f_m)


def setup_inputs(seed: int = 0) -> dict:
    key = jax.random.key(seed)
    ks = iter(jax.random.split(key, 64))
    nrm = lambda shape, s: s * jax.random.normal(next(ks), shape, F32)
    unif = lambda shape, lo, hi: jax.random.uniform(next(ks), shape, F32, lo, hi)
    gain = lambda shape: 1.0 + nrm(shape, 0.01)
    L, D = DEPTH, D_MODEL
    return {
        'x_prompt': nrm((BATCH, SEQ, D), 1.0),
        'x_sample': nrm((DEC_BATCH, DEC_SEQ, D), 1.0),
        'c': nrm((DEC_BATCH, D), 1.0),
        'state_rwkv': nrm((DEC_BATCH, L, N_DIR, H_A, HEAD_DIM, HEAD_DIM), 0.1),
        'state_mlstm_C': nrm((DEC_BATCH, L, N_DIR, H_D, HEAD_DIM, HEAD_DIM), 0.1),
        'state_mlstm_n': nrm((DEC_BATCH, L, N_DIR, H_D, HEAD_DIM), 0.1),
        'state_mlstm_m': nrm((DEC_BATCH, L, N_DIR, H_D), 1.0),
        'c_ctx': nrm((D,), 1.0),
        'w_mod': nrm((L, D, 6 * D), 0.5 * D ** -0.5),
        'b_mod': nrm((L, 6 * D), 0.01),
        'norm1_g': gain((L, D)),
        'norm2_g': gain((L, D)),
        'w_in': nrm((L, D, D_IN), D ** -0.5),
        'w_out': nrm((L, D_MIX, D), D_MIX ** -0.5),
        'rwkv_mu': unif((L, A_W), 0.0, 1.0),
        'rwkv_w0': unif((L, N_DIR, D_GROUP), -6.0, 1.0),
        'rwkv_w_up': nrm((L, N_DIR, RANK_W, D_GROUP), 0.1 * RANK_W ** -0.5),
        'rwkv_a0': nrm((L, N_DIR, D_GROUP), 0.1),
        'rwkv_a_up': nrm((L, N_DIR, RANK_A, D_GROUP), 0.1 * RANK_A ** -0.5),
        'rwkv_g_up': nrm((L, RANK_G, D_GROUP), RANK_G ** -0.5),
        'rwkv_k_k': 0.85 + nrm((L, D_GROUP), 0.02),
        'rwkv_k_a': gain((L, D_GROUP)),
        'rwkv_r_k': nrm((L, H_A, HEAD_DIM), 0.1),
        'rwkv_ln_g': gain((L, D_GROUP)),
        'rwkv_ln_b': nrm((L, D_GROUP), 0.01),
        'pool_w': nrm((L, N_POOL, POOL_CH, POOL_CH), POOL_CH ** -0.5),
        'pool_scale': gain((L, D_GROUP)),
        'conv_dw': nrm((L, CONV_W, D_GROUP), CONV_W ** -0.5),
        'conv_b': nrm((L, D_GROUP), 0.01),
        'conv_ln_g': gain((L, D_GROUP)),
        'conv_ln_b': nrm((L, D_GROUP), 0.01),
        'conv_pw': nrm((L, D_GROUP, D_GROUP), D_GROUP ** -0.5),
        'mlstm_qk_conv': nrm((L, QK_CONV_W, 2 * D_GROUP), QK_CONV_W ** -0.5),
        'mlstm_i_bias': nrm((L, N_DIR * H_D), 0.1),
        'mlstm_f_bias': jnp.linspace(3.0, 6.0, N_DIR * H_D, dtype=F32)[None, :] + nrm((L, N_DIR * H_D), 0.1),
        'mlstm_hn_g': gain((L, D_GROUP)),
        'mlp_w1': nrm((L, D, D_FF), D ** -0.5),
        'mlp_b1': nrm((L, D_FF), 0.01),
        'mlp_w2': nrm((L, D_FF, D), D_FF ** -0.5),
        'mlp_b2': nrm((L, D), 0.01),
        'final_g': gain((D,)),
    }


def reference(x_prompt, x_sample, c, state_rwkv, state_mlstm_C, state_mlstm_n, state_mlstm_m, c_ctx,
              w_mod, b_mod, norm1_g, norm2_g, w_in, w_out,
              rwkv_mu, rwkv_w0, rwkv_w_up, rwkv_a0, rwkv_a_up, rwkv_g_up, rwkv_k_k, rwkv_k_a, rwkv_r_k,
              rwkv_ln_g, rwkv_ln_b, pool_w, pool_scale, conv_dw, conv_b, conv_ln_g, conv_ln_b, conv_pw,
              mlstm_qk_conv, mlstm_i_bias, mlstm_f_bias, mlstm_hn_g,
              mlp_w1, mlp_b1, mlp_w2, mlp_b2, final_g):
    P = dict(norm1_g=norm1_g, norm2_g=norm2_g, w_in=w_in, w_out=w_out,
             rwkv_mu=rwkv_mu, rwkv_w0=rwkv_w0, rwkv_w_up=rwkv_w_up, rwkv_a0=rwkv_a0, rwkv_a_up=rwkv_a_up,
             rwkv_g_up=rwkv_g_up, rwkv_k_k=rwkv_k_k, rwkv_k_a=rwkv_k_a, rwkv_r_k=rwkv_r_k,
             rwkv_ln_g=rwkv_ln_g, rwkv_ln_b=rwkv_ln_b, pool_w=pool_w, pool_scale=pool_scale,
             conv_dw=conv_dw, conv_b=conv_b, conv_ln_g=conv_ln_g, conv_ln_b=conv_ln_b, conv_pw=conv_pw,
             mlstm_qk_conv=mlstm_qk_conv, mlstm_i_bias=mlstm_i_bias, mlstm_f_bias=mlstm_f_bias,
             mlstm_hn_g=mlstm_hn_g, mlp_w1=mlp_w1, mlp_b1=mlp_b1, mlp_w2=mlp_w2, mlp_b2=mlp_b2)
    bp = x_prompt.shape[0]
    zero_states = (jnp.zeros((bp, N_DIR, H_A, HEAD_DIM, HEAD_DIM), F32),
                   jnp.zeros((bp, N_DIR, H_D, HEAD_DIM, HEAD_DIM), F32),
                   jnp.zeros((bp, N_DIR, H_D, HEAD_DIM), F32),
                   jnp.zeros((bp, N_DIR, H_D), F32))
    xp, xs = x_prompt, x_sample
    new_r, new_c, new_n, new_m = [], [], [], []
    for l in range(DEPTH):
        mod_ctx = (jax.nn.silu(c_ctx) @ w_mod[l] + b_mod[l])[None, :]
        xp, (sr, sc, sn, sm) = trunk_layer(xp, mod_ctx, P, l, zero_states, grid=False)
        new_r.append(sr)
        new_c.append(sc)
        new_n.append(sn)
        new_m.append(sm)
        mod_lat = jax.nn.silu(c) @ w_mod[l] + b_mod[l]
        cached = (state_rwkv[:, l], state_mlstm_C[:, l], state_mlstm_n[:, l], state_mlstm_m[:, l])
        xs, _ = trunk_layer(xs, mod_lat, P, l, cached, grid=True)
    y_prompt = rms_norm(xp, final_g)
    y_sample = rms_norm(xs, final_g)
    dt = x_prompt.dtype
    return (y_prompt, y_sample,
            jnp.stack(new_r, axis=1).astype(dt), jnp.stack(new_c, axis=1).astype(dt),
            jnp.stack(new_n, axis=1).astype(dt), jnp.stack(new_m, axis=1).astype(dt))
```

```cpp
#ifndef CPU_EMU
#include <hip/hip_runtime.h>
#include <hip/hip_cooperative_groups.h>
#endif
#include <cstdio>
#include <cstdint>
#include <cmath>

#define DEV __device__ __forceinline__
#ifdef CPU_EMU
#define LDS_SYNC() __syncthreads()
#else
#define LDS_SYNC() do { asm volatile("s_waitcnt lgkmcnt(0)" ::: "memory"); __builtin_amdgcn_s_barrier(); asm volatile("" ::: "memory"); } while (0)
#endif

#ifndef CFG_BATCH
#define CFG_BATCH 32
#define CFG_SEQ 256
#define CFG_DEC_BATCH 2
#define CFG_DEC_SEQ 4096
#define CFG_DEPTH 4
#endif
constexpr int D = 1024, BATCH = CFG_BATCH, SEQ = CFG_SEQ, DEC_BATCH = CFG_DEC_BATCH, DEC_SEQ = CFG_DEC_SEQ, DEPTH = CFG_DEPTH;
constexpr int M_CTX = BATCH * SEQ, M_LAT = DEC_BATCH * DEC_SEQ, M = M_CTX + M_LAT;
constexpr int NMOD = 1 + DEC_BATCH;
constexpr int D_IN = 2832, ZW = 3072, DFF = 4096, DG = 256;
constexpr int GRID_W = 64, GRID_ROWS = DEC_SEQ / GRID_W;
constexpr int ZB = 1024, ZC = 1280, ZD = 1792;
constexpr int ZD_V = ZD + 512, ZD_I = ZD + 768, ZD_F = ZD + 776, ZD_O = ZD + 784;
static_assert(M_CTX % 256 == 0 && M_LAT % 256 == 0 && SEQ % 64 == 0 && DEC_SEQ % 64 == 0, "shape");

enum { I_XP = 0, I_XS, I_C, I_SRWKV, I_SC, I_SN, I_SM, I_CCTX, I_WMOD, I_BMOD, I_N1G, I_N2G, I_WIN, I_WOUT,
       I_MU, I_W0, I_WUP, I_A0, I_AUP, I_GUP, I_KK, I_KA, I_RK, I_LNG, I_LNB, I_POOLW, I_POOLS, I_CDW, I_CB, I_CLNG, I_CLNB, I_CPW,
       I_QKCONV, I_IB, I_FB, I_HNG, I_W1, I_B1, I_W2, I_B2, I_FG, N_IN };

typedef unsigned short bf16_t;
typedef _Float16 f16;
constexpr size_t MiB = 1u << 20;
constexpr size_t WS_CTL = 0, CTL_BYTES = 1 * MiB;
constexpr size_t WS_MOD = 65536;
static_assert(WS_MOD + (size_t)DEPTH * NMOD * 6144 * 4 <= CTL_BYTES, "mod");
constexpr size_t WS_WIN = CTL_BYTES;
constexpr size_t WS_WOUT = WS_WIN + (size_t)DEPTH * ZW * D * 2;
constexpr size_t WS_W1 = WS_WOUT + (size_t)DEPTH * D * D * 2;
constexpr size_t WS_W2 = WS_W1 + (size_t)DEPTH * DFF * D * 2;
constexpr size_t WS_H = WS_W2 + (size_t)DEPTH * D * DFF * 2;
constexpr size_t WS_OV = WS_H + (size_t)M * D * 2;
constexpr size_t WS_Z = WS_OV;
constexpr int RCH_REC = 10496;
constexpr size_t WS_RCH = WS_Z + (size_t)M * ZW * 2;
constexpr size_t WS_RV = WS_RCH + (size_t)8 * (M / 16) * RCH_REC;
constexpr size_t WS_RG = WS_RV + (size_t)M * DG * 2;
constexpr size_t WS_RY = WS_RG + (size_t)M * DG * 2;
constexpr int NTC = M / 64;
constexpr size_t WS_UP = WS_RY + (size_t)2 * M * DG * 2;
constexpr size_t WS_CP = WS_UP + (size_t)2 * NTC * 4 * 4096 * 2;
constexpr size_t WS_NU = WS_CP + (size_t)2 * NTC * 4 * 4096 * 2;
constexpr size_t WS_NP = WS_NU + (size_t)2 * NTC * 4 * 64 * 4;
constexpr size_t WS_AB = WS_NP + (size_t)2 * NTC * 4 * 64 * 4;
constexpr size_t WS_MP = WS_AB + (size_t)2 * NTC * 4 * 2 * 4;
constexpr size_t WS_SW = WS_MP + (size_t)2 * NTC * 4 * 4;
constexpr int SW_WUP = 0, SW_AUP = 32768, SW_GUP = 65536, SW_CPW = 98304, SW_POOL = 163840, SW_LAYER = 180224;
constexpr size_t WS_END_A = WS_SW + (size_t)DEPTH * SW_LAYER * 2;
constexpr size_t WS_END_B = WS_OV + (size_t)M * DFF * 2;
constexpr size_t WS_END = WS_END_A > WS_END_B ? WS_END_A : WS_END_B;
#if CFG_BATCH == 32 && CFG_DEC_SEQ == 4096
static_assert(WS_END <= (size_t)384 * MiB, "workspace must fit 4x the largest tensor (384 MiB)");
#endif

constexpr int LDS_BYTES = 147456;

struct Params { const float* in[N_IN]; float* out; unsigned char* ws; };
#ifdef CPU_EMU
#define INP(i) (P.in[i])
#else
__device__ __forceinline__ const float* inp_(const Params& P, int i) { asm volatile("" : "+s"(i)); return P.in[i]; }
#define INP(i) inp_(P, (i))
#endif
#ifdef CPU_EMU
#define TID() ((int)threadIdx.x)
#else
__device__ __forceinline__ int tid_() { int t = threadIdx.x; asm volatile("" : "+v"(t)); return t; }
#define TID() tid_()
#endif

DEV float bf2f(bf16_t h) { unsigned u = (unsigned)h << 16; return __builtin_bit_cast(float, u); }
DEV bf16_t f2bf(float f) { unsigned u = __builtin_bit_cast(unsigned, f); return (bf16_t)((u + 0x7fffu + ((u >> 16) & 1u)) >> 16); }
DEV unsigned pk2(float lo, float hi) { return (unsigned)f2bf(lo) | ((unsigned)f2bf(hi) << 16); }
#ifdef CPU_EMU
DEV float fexp(float x) { return expf(x); }
DEV float flog(float x) { return logf(x); }
DEV float frcp(float x) { return 1.f / x; }
DEV float frsq(float x) { return 1.f / sqrtf(x); }
#else
DEV float fexp(float x) { return __builtin_amdgcn_exp2f(x * 1.44269504088896341f); }
DEV float flog(float x) { return __builtin_amdgcn_logf(x) * 0.69314718055994531f; }
DEV float frcp(float x) { return __builtin_amdgcn_rcpf(x); }
DEV float frsq(float x) { return __builtin_amdgcn_rsqf(x); }
#endif
DEV float sigm(float x) { return frcp(1.f + fexp(-x)); }
DEV float silu_(float x) { return x * sigm(x); }
DEV float softplus_(float x) { return fmaxf(x, 0.f) + flog(1.f + fexp(-fabsf(x))); }
DEV float tanh_(float x) { return 1.f - 2.f * frcp(1.f + fexp(2.f * x)); }
#ifdef CPU_EMU
DEV float dpp_xor1(float v) { return __shfl_xor(v, 1); }
DEV float dpp_xor2(float v) { return __shfl_xor(v, 2); }
DEV float dpp_hmir(float v) { const int l = threadIdx.x & 63; return __shfl(v, (l & ~7) | (7 - (l & 7))); }
DEV float dpp_mir(float v) { const int l = threadIdx.x & 63; return __shfl(v, (l & ~15) | (15 - (l & 15))); }
DEV float lane_get(float v, int src) { return __shfl(v, src); }
#else
template <int CTRL> DEV float dpp_(float v) { return __builtin_bit_cast(float, __builtin_amdgcn_update_dpp(0, __builtin_bit_cast(int, v), CTRL, 0xF, 0xF, true)); }
DEV float dpp_xor1(float v) { return dpp_<0xB1>(v); }
DEV float dpp_xor2(float v) { return dpp_<0x4E>(v); }
DEV float dpp_hmir(float v) { return dpp_<0x141>(v); }
DEV float dpp_mir(float v) { return dpp_<0x140>(v); }
DEV float lane_get(float v, int src) { return __builtin_bit_cast(float, __builtin_amdgcn_readlane(__builtin_bit_cast(int, v), src)); }
#endif
#ifdef CPU_EMU
DEV float lane_up(float v, int delta) { const int l = threadIdx.x & 63; return __shfl(v, l >= delta ? l - delta : l); }
#else
DEV float lane_up(float v, int delta) { return __shfl_up(v, delta); }
#endif
DEV float wave_incl_sum(float x, int lane) {
#pragma unroll
    for (int o = 1; o < 64; o <<= 1) { const float y = lane_up(x, o); if (lane >= o) x += y; }
    return x;
}
DEV float wave_incl_max(float x, int lane) {
#pragma unroll
    for (int o = 1; o < 64; o <<= 1) { const float y = lane_up(x, o); if (lane >= o) x = fmaxf(x, y); }
    return x;
}
DEV float sum16(float v) {
    v += dpp_xor1(v); v += dpp_xor2(v); v += dpp_hmir(v); v += dpp_mir(v); return v;
}
DEV float wave_sum(float v) {
    v = sum16(v);
    return (lane_get(v, 0) + lane_get(v, 16)) + (lane_get(v, 32) + lane_get(v, 48));
}
struct SeqInfo { int base, T, t, lat, sidx; };
DEV SeqInfo seq_of(int m) {
    SeqInfo s;
    if (m < M_CTX) { s.lat = 0; s.sidx = m / SEQ; s.T = SEQ; s.base = s.sidx * SEQ; s.t = m - s.base; }
    else { const int mm = m - M_CTX; s.lat = 1; s.sidx = mm / DEC_SEQ; s.T = DEC_SEQ; s.base = M_CTX + s.sidx * DEC_SEQ; s.t = mm - s.sidx * DEC_SEQ; }
    return s;
}
DEV int mod_index(int m) { return m < M_CTX ? 0 : 1 + (m - M_CTX) / DEC_SEQ; }
DEV const float* mod_vec(const Params& P, int l, int j) { return (const float*)(P.ws + WS_MOD) + ((size_t)l * NMOD + j) * 6144; }
DEV const float* xrow(const Params& P, bool from_input, int m) {
    if (from_input) return m < M_CTX ? INP(I_XP) + (size_t)m * D : INP(I_XS) + (size_t)(m - M_CTX) * D;
    return P.out + (size_t)m * D;
}

namespace pg8 {
typedef short bf16x8 __attribute__((ext_vector_type(8)));
typedef float f32x4 __attribute__((ext_vector_type(4)));
typedef unsigned u32x4 __attribute__((ext_vector_type(4)));
constexpr int BM = 256, BK = 64, HALF = 128, HTB = HALF * BK * 2, STAGE_BYTES = 8 * HTB, NXCD = 8, WGM = 8;
struct Unit { int pm, pn; };
struct Gemm { const bf16_t* A; const bf16_t* Bt; int M, N, K; };
struct StaticOrder {
    int nM, nN, nwg, G, c;
    __host__ __device__ void init(int M_, int N_, int G_, int c_) { nM = M_ / BM; nN = N_ / BM; nwg = nM * nN; G = G_; c = c_; }
    __host__ __device__ bool next(int i, Unit& u) const {
        const long L = (long)i * G + c; if (L >= nwg) return false;
        int wgid = (int)L; { const int q = nwg / NXCD, r = nwg % NXCD, xcd = wgid % NXCD, off = wgid / NXCD; wgid = (xcd < r ? xcd * (q + 1) : r * (q + 1) + (xcd - r) * q) + off; }
        const int nig = WGM * nN, gid = wgid / nig, fm = gid * WGM, gsz = (nM - fm) < WGM ? (nM - fm) : WGM;
        u.pm = fm + ((wgid % nig) % gsz); u.pn = (wgid % nig) / gsz; return true;
    }
    __device__ __forceinline__ void a_ready(const Unit&) const {}
    __device__ __forceinline__ void done(const Unit&) const {}
};

#ifdef CPU_EMU
#define PG8_LAS
DEV unsigned cvt_pk_bf16(float lo, float hi) { return pk2(lo, hi); }
template <class Epi, class Sched, bool ALIGN_EPI = false, bool SP2 = false>
DEV void gemm_phase(unsigned char* lds, const Gemm g, const Sched& S, const Epi& E) {
    const int tid = TID(), wid = tid >> 6, lane = tid & 63, wr = wid >> 2, wc = wid & 3, fr = lane & 15, fq = lane >> 4;
    Unit cur;
    for (int ui = 0; S.next(ui, cur); ++ui) {
        f32x4 acc[2][2][4][2];
        for (int ai = 0; ai < 2; ++ai) for (int bj = 0; bj < 2; ++bj) for (int m = 0; m < 4; ++m) for (int n = 0; n < 2; ++n) for (int j = 0; j < 4; ++j) {
            const int row = cur.pm * BM + ai * HALF + wr * 64 + m * 16 + fr;
            const int col = cur.pn * BM + bj * HALF + wc * 32 + (E.perm ? 8 * fq + 4 * n + j : 16 * n + 4 * fq + j);
            const bf16_t* a = g.A + (size_t)row * g.K; const bf16_t* b = g.Bt + (size_t)col * g.K;
            float s = 0.f; for (int k = 0; k < g.K; ++k) s += bf2f(a[k]) * bf2f(b[k]);
            acc[ai][bj][m][n][j] = s;
        }
        E(acc, cur, wr, wc, fr, fq);
    }
}
#else
#define PG8_LAS __attribute__((address_space(3)))
__host__ __device__ __forceinline__ int lds_byte(int r, int c) { const int st = (r >> 4) * 2 + (c >> 5), rr = r & 15, cc = c & 31, ob = rr * 64 + cc * 2; return st * 1024 + (ob ^ (((ob >> 9) & 1) << 5)); }
__host__ __device__ __forceinline__ void stage_rc(int b, int& R, int& C) { const int st = b / 1024, sb = b % 1024, swz = sb ^ (((sb >> 9) & 1) << 5); R = (st >> 1) * 16 + swz / 64; C = (st & 1) * 32 + (swz % 64) / 2; }
__host__ __device__ __forceinline__ int perm32(int rho) { const int n = rho >> 4, i = rho & 15; return 8 * (i >> 2) + 4 * n + (i & 3); }
__device__ __forceinline__ unsigned cvt_pk_bf16(float lo, float hi) { unsigned r; asm volatile("v_cvt_pk_bf16_f32 %0, %1, %2" : "=v"(r) : "v"(lo), "v"(hi)); return r; }

template <class Epi, class Sched, bool ALIGN_EPI = false, bool SP2 = false>
__device__ __forceinline__ void gemm_phase(PG8_LAS unsigned char* lds, const Gemm g, const Sched& S, const Epi& E) {
    const int tid = TID(), wid = __builtin_amdgcn_readfirstlane(tid >> 6), lane = tid & 63, wr = wid >> 2, wc = wid & 3, fr = lane & 15, fq = lane >> 4;
    const int K = g.K, nt = K / BK;
    unsigned voffA[2], voffB[2];
#pragma unroll
    for (int i = 0; i < 2; ++i) { int R, C; stage_rc(tid * 16 + i * 8192, R, C); const int Rb = E.perm ? ((R & ~31) + perm32(R & 31)) : R;
        voffA[i] = (unsigned)(R * K + C) * 2u; voffB[i] = (unsigned)(Rb * K + C) * 2u; }
    const size_t kstep = (size_t)(BK * 2);
    const size_t hstep = (size_t)HALF * K * 2;
    const size_t tstep = 2 * hstep;
    const unsigned ldsw = (unsigned)wid * 1024u;
    const int aoff = lds_byte(wr * 64 + fr, fq * 8), boff = lds_byte(wc * 32 + fr, fq * 8);
#define PG8_SA(b, h) (((b) * 2 + (h)) * HTB)
#define PG8_SB(b, h) ((4 + (b) * 2 + (h)) * HTB)
#define PG8_STAGE(bufoff, gbase, voff) do { _Pragma("unroll") for (int _i = 0; _i < 2; ++_i) \
        __builtin_amdgcn_global_load_lds((const unsigned*)((const char*)(gbase) + (voff)[_i]), (PG8_LAS unsigned*)(lds + (bufoff) + ldsw + _i * 8192), 16, 0, 0); } while (0)
#define PG8_LDA(dst, b, h) do { _Pragma("unroll") for (int m = 0; m < 4; ++m) _Pragma("unroll") for (int k = 0; k < 2; ++k) dst[m][k] = *(const PG8_LAS bf16x8*)(lds + PG8_SA(b, h) + aoff + m * 2048 + k * 1024); } while (0)
#define PG8_LDB(dst, b, h) do { _Pragma("unroll") for (int n = 0; n < 2; ++n) _Pragma("unroll") for (int k = 0; k < 2; ++k) dst[n][k] = *(const PG8_LAS bf16x8*)(lds + PG8_SB(b, h) + boff + n * 2048 + k * 1024); } while (0)
#define PG8_MMA(ai, bj, At, Bt) do { __builtin_amdgcn_s_setprio(1); _Pragma("unroll") for (int m = 0; m < 4; ++m) _Pragma("unroll") for (int n = 0; n < 2; ++n) _Pragma("unroll") for (int k = 0; k < 2; ++k) \
        acc[ai][bj][m][n] = __builtin_amdgcn_mfma_f32_16x16x32_bf16(Bt[n][k], At[m][k], acc[ai][bj][m][n], 0, 0, 0); __builtin_amdgcn_s_setprio(0); } while (0)
#define PG8_WAIT_V(n) asm volatile("s_waitcnt vmcnt(" #n ")" ::: "memory")
#define PG8_WAIT_L(n) asm volatile("s_waitcnt lgkmcnt(" #n ")" ::: "memory")
#define PG8_BAR __builtin_amdgcn_s_barrier()
#define PG8_SCHED __builtin_amdgcn_sched_barrier(0)
    Unit cur, nxt; int ui = 0;
    if (!S.next(0, cur)) return;
    f32x4 acc[2][2][4][2];
#pragma unroll
    for (int a = 0; a < 2; ++a)
#pragma unroll
        for (int b = 0; b < 2; ++b)
#pragma unroll
            for (int m = 0; m < 4; ++m)
#pragma unroll
                for (int n = 0; n < 2; ++n) acc[a][b][m][n] = (f32x4){0.f, 0.f, 0.f, 0.f};
    bf16x8 At[4][2], B0[2][2], B1[2][2];
    const char* cA = (const char*)g.A + (size_t)cur.pm * tstep; const char* cB = (const char*)g.Bt + (size_t)cur.pn * tstep;
    S.a_ready(cur);
    if constexpr (SP2) {
        PG8_STAGE(PG8_SB(0, 0), cB, voffB); PG8_STAGE(PG8_SB(0, 1), cB + hstep, voffB); PG8_STAGE(PG8_SA(0, 0), cA, voffA); PG8_STAGE(PG8_SA(0, 1), cA + hstep, voffA);
        if (wr == 1) PG8_BAR;
        PG8_WAIT_V(2); PG8_BAR;
        PG8_STAGE(PG8_SB(1, 0), cB + kstep, voffB); PG8_STAGE(PG8_SA(1, 0), cA + kstep, voffA); PG8_STAGE(PG8_SB(1, 1), cB + hstep + kstep, voffB);
        PG8_WAIT_V(6); PG8_BAR;
    } else {
        PG8_STAGE(PG8_SB(0, 0), cB, voffB); PG8_STAGE(PG8_SA(0, 0), cA, voffA); PG8_STAGE(PG8_SB(0, 1), cB + hstep, voffB); PG8_STAGE(PG8_SA(0, 1), cA + hstep, voffA);
        if (wr == 1) PG8_BAR;
        PG8_WAIT_V(4); PG8_BAR;
        PG8_STAGE(PG8_SB(1, 0), cB + kstep, voffB); PG8_STAGE(PG8_SA(1, 0), cA + kstep, voffA); PG8_STAGE(PG8_SB(1, 1), cB + hstep + kstep, voffB);
        PG8_WAIT_V(6); PG8_BAR;
    }
    for (;;) {
        const bool has_next = S.next(ui + 1, nxt);
        const char* nA = has_next ? (const char*)g.A + (size_t)nxt.pm * tstep : cA; const char* nB = has_next ? (const char*)g.Bt + (size_t)nxt.pn * tstep : cB;
        for (int t = 0; t < nt; t += 2) {
            const bool last = (t == nt - 2);
            const char* a1 = cA + (size_t)(t + 1) * kstep;
            const char* a2 = last ? nA : cA + (size_t)(t + 2) * kstep; const char* b2 = last ? nB : cB + (size_t)(t + 2) * kstep;
            const char* a3 = a2 + kstep; const char* b3 = b2 + kstep;
            if (last && has_next) S.a_ready(nxt);
            if constexpr (SP2) {
            PG8_LDB(B0, 0, 0); PG8_LDB(B1, 0, 1); PG8_SCHED; PG8_LDA(At, 0, 0); PG8_STAGE(PG8_SA(1, 1), a1 + hstep, voffA);
            PG8_WAIT_V(8); PG8_WAIT_L(0); PG8_BAR; PG8_MMA(0, 0, At, B0); PG8_MMA(0, 1, At, B1); PG8_BAR; PG8_SCHED;
            PG8_LDA(At, 0, 1); PG8_STAGE(PG8_SB(0, 0), b2, voffB); PG8_STAGE(PG8_SB(0, 1), b2 + hstep, voffB); PG8_STAGE(PG8_SA(0, 0), a2, voffA);
            PG8_WAIT_V(8); PG8_WAIT_L(0); PG8_BAR; PG8_MMA(1, 0, At, B0); PG8_MMA(1, 1, At, B1); PG8_BAR; PG8_SCHED;
            PG8_LDB(B0, 1, 0); PG8_LDB(B1, 1, 1); PG8_SCHED; PG8_LDA(At, 1, 0); PG8_STAGE(PG8_SA(0, 1), a2 + hstep, voffA);
            PG8_WAIT_V(8); PG8_WAIT_L(0); PG8_BAR; PG8_MMA(0, 0, At, B0); PG8_MMA(0, 1, At, B1); PG8_BAR; PG8_SCHED;
            PG8_LDA(At, 1, 1); PG8_STAGE(PG8_SB(1, 0), b3, voffB); PG8_STAGE(PG8_SB(1, 1), b3 + hstep, voffB); PG8_STAGE(PG8_SA(1, 0), a3, voffA);
            PG8_WAIT_V(8); PG8_WAIT_L(0); PG8_BAR; PG8_MMA(1, 0, At, B0); PG8_MMA(1, 1, At, B1); PG8_BAR; PG8_SCHED;
            } else {
            PG8_LDB(B0, 0, 0); PG8_SCHED; PG8_LDA(At, 0, 0); PG8_STAGE(PG8_SA(1, 1), a1 + hstep, voffA);
            PG8_WAIT_L(8); PG8_BAR; PG8_WAIT_L(0); PG8_MMA(0, 0, At, B0); PG8_BAR; PG8_SCHED;
            PG8_LDB(B1, 0, 1); PG8_STAGE(PG8_SB(0, 0), b2, voffB);
            PG8_BAR; PG8_WAIT_L(0); PG8_MMA(0, 1, At, B1); PG8_BAR;
            PG8_LDA(At, 0, 1); PG8_STAGE(PG8_SA(0, 0), a2, voffA);
            PG8_BAR; PG8_WAIT_L(0); PG8_MMA(1, 0, At, B0); PG8_BAR; PG8_SCHED;
            PG8_STAGE(PG8_SB(0, 1), b2 + hstep, voffB);
            PG8_WAIT_V(6); PG8_BAR; PG8_MMA(1, 1, At, B1); PG8_BAR;
            PG8_LDB(B0, 1, 0); PG8_SCHED; PG8_LDA(At, 1, 0); PG8_STAGE(PG8_SA(0, 1), a2 + hstep, voffA);
            PG8_WAIT_L(8); PG8_BAR; PG8_WAIT_L(0); PG8_MMA(0, 0, At, B0); PG8_BAR; PG8_SCHED;
            PG8_LDB(B1, 1, 1); PG8_STAGE(PG8_SB(1, 0), b3, voffB);
            PG8_BAR; PG8_WAIT_L(0); PG8_MMA(0, 1, At, B1); PG8_BAR;
            PG8_LDA(At, 1, 1); PG8_STAGE(PG8_SA(1, 0), a3, voffA);
            PG8_BAR; PG8_WAIT_L(0); PG8_MMA(1, 0, At, B0); PG8_BAR; PG8_SCHED;
            PG8_STAGE(PG8_SB(1, 1), b3 + hstep, voffB);
            PG8_WAIT_V(6); PG8_BAR; PG8_MMA(1, 1, At, B1); PG8_BAR;
            }
        }
        if constexpr (ALIGN_EPI) { if (wr == 0) PG8_BAR; }
        E(acc, cur, wr, wc, fr, fq); S.done(cur);
        if (!has_next) break;
#pragma unroll
        for (int a = 0; a < 2; ++a)
#pragma unroll
            for (int b = 0; b < 2; ++b)
#pragma unroll
                for (int m = 0; m < 4; ++m)
#pragma unroll
                    for (int n = 0; n < 2; ++n) acc[a][b][m][n] = (f32x4){0.f, 0.f, 0.f, 0.f};
        cur = nxt; cA = nA; cB = nB; ++ui;
        if constexpr (ALIGN_EPI) { if (wr == 1) PG8_BAR; }
    }
    PG8_WAIT_V(0);
    if constexpr (!ALIGN_EPI) { if (wr == 0) PG8_BAR; }
    PG8_BAR;
#undef PG8_SA
#undef PG8_SB
#undef PG8_STAGE
#undef PG8_LDA
#undef PG8_LDB
#undef PG8_MMA
#undef PG8_WAIT_V
#undef PG8_WAIT_L
#undef PG8_BAR
#undef PG8_SCHED
}
#endif

template <int ACT  > struct EpiBf16 {
    static constexpr bool PERM = true, AFTER_DRAIN = false;
    bf16_t* O; int ldc; const float* bias;
    DEV void operator()(const f32x4 (&acc)[2][2][4][2], const Unit& u, int wr, int wc, int fr, int fq) const {
        const int row0 = u.pm * BM + wr * 64 + fr, col0 = u.pn * BM + wc * 32 + 8 * fq;
        f32x4 bv[2][2];
#pragma unroll
        for (int bj = 0; bj < 2; ++bj)
#pragma unroll
            for (int n = 0; n < 2; ++n) bv[bj][n] = bias ? *(const f32x4*)(bias + col0 + bj * HALF + 4 * n) : (f32x4){0.f, 0.f, 0.f, 0.f};
#pragma unroll
        for (int ai = 0; ai < 2; ++ai)
#pragma unroll
            for (int m = 0; m < 4; ++m) { bf16_t* rowp = O + (size_t)(row0 + ai * HALF + m * 16) * ldc + col0;
#pragma unroll
                for (int bj = 0; bj < 2; ++bj) { f32x4 v0 = acc[ai][bj][m][0] + bv[bj][0], v1 = acc[ai][bj][m][1] + bv[bj][1];
                    if (ACT == 1) {
#pragma unroll
                        for (int j = 0; j < 4; ++j) { const float a = fmaxf(v0[j], 0.f), b = fmaxf(v1[j], 0.f); v0[j] = a * a; v1[j] = b * b; } }
                    u32x4 w; w.x = cvt_pk_bf16(v0[0], v0[1]); w.y = cvt_pk_bf16(v0[2], v0[3]); w.z = cvt_pk_bf16(v1[0], v1[1]); w.w = cvt_pk_bf16(v1[2], v1[3]);
                    *(u32x4*)(rowp + bj * HALF) = w; } }
    }
};
struct EpiRes {
    static constexpr bool PERM = false, AFTER_DRAIN = false;
    const float* base_ctx; const float* base_lat; float* out; const float* gate; const float* bias;
    DEV void operator()(const f32x4 (&acc)[2][2][4][2], const Unit& u, int wr, int wc, int fr, int fq) const {
        const int col0 = u.pn * BM + wc * 32 + 4 * fq;
#pragma unroll
        for (int ai = 0; ai < 2; ++ai)
#pragma unroll
            for (int m = 0; m < 4; ++m) { const int r = u.pm * BM + ai * HALF + wr * 64 + m * 16 + fr;
                const float* bs = r < M_CTX ? base_ctx + (size_t)r * D : base_lat + (size_t)(r - M_CTX) * D;
                const float* gt = gate + (size_t)mod_index(r) * 6144; float* orow = out + (size_t)r * D;
#pragma unroll
                for (int bj = 0; bj < 2; ++bj)
#pragma unroll
                    for (int n = 0; n < 2; ++n) { const int c = col0 + bj * HALF + n * 16;
                        f32x4 v = acc[ai][bj][m][n]; if (bias) v = v + *(const f32x4*)(bias + c);
                        const f32x4 o = *(const f32x4*)(bs + c) + *(const f32x4*)(gt + c) * v; *(f32x4*)(orow + c) = o; } }
    }
};
struct EpiAny {
    static constexpr bool AFTER_DRAIN = false;
    int mode; bool perm; EpiBf16<0> b0; EpiBf16<1> b1; EpiRes rs;
    DEV void operator()(const f32x4 (&acc)[2][2][4][2], const Unit& u, int wr, int wc, int fr, int fq) const {
        if (mode == 0) b0(acc, u, wr, wc, fr, fq); else if (mode == 1) b1(acc, u, wr, wc, fr, fq); else rs(acc, u, wr, wc, fr, fq);
    }
};
}

#ifdef CPU_EMU
#define LDSP(p) (p)
#else
#define LDSP(p) ((PG8_LAS unsigned char*)(p))
#endif

constexpr int LT = 72;
#ifdef CPU_EMU
DEV pg8::f32x4 mfma16(pg8::bf16x8 a, pg8::bf16x8 b, pg8::f32x4 c) { return emu::mfma16(a, b, c); }
#else
DEV pg8::f32x4 mfma16(pg8::bf16x8 a, pg8::bf16x8 b, pg8::f32x4 c) { return __builtin_amdgcn_mfma_f32_16x16x32_bf16(a, b, c, 0, 0, 0); }
#endif
typedef f16 h4 __attribute__((ext_vector_type(4)));
#ifdef CPU_EMU
DEV pg8::f32x4 mfma16h(h4 a, h4 b, pg8::f32x4 c) { return emu::mfma16h(a, b, c); }
#else
DEV pg8::f32x4 mfma16h(h4 a, h4 b, pg8::f32x4 c) { return __builtin_amdgcn_mfma_f32_16x16x16f16(a, b, c, 0, 0, 0); }
#endif
DEV h4 cvt_h4(pg8::f32x4 v) { return (h4){(f16)v[0], (f16)v[1], (f16)v[2], (f16)v[3]}; }
DEV pg8::f32x4 tile_mm64(const bf16_t* A, int r0, const bf16_t* Bt, int c0, int fr, int fq) {
    pg8::f32x4 acc = {0.f, 0.f, 0.f, 0.f};
#pragma unroll
    for (int ks = 0; ks < 2; ++ks) { const pg8::bf16x8 a = *(const pg8::bf16x8*)(A + (r0 + fr) * LT + ks * 32 + fq * 8), b = *(const pg8::bf16x8*)(Bt + (c0 + fr) * LT + ks * 32 + fq * 8); acc = mfma16(a, b, acc); }
    return acc;
}

DEV void transpose_item(const float* W, int K, int N, int Npad, bf16_t* WT, int item, float* s  ) {
    const int tid = TID(), nblk = Npad / 256, kb = item / nblk, nb = item % nblk, k0 = kb * 64, n0 = nb * 256;
    {
        const int n = tid & 255, kp = tid >> 8; const bool ok = n0 + n < N; const float* wp = W + (size_t)(k0 + kp) * N + n0 + (ok ? n : 0);
        float tv[32];
#pragma unroll
        for (int i = 0; i < 32; ++i) tv[i] = wp[(size_t)(2 * i) * N];
#pragma unroll
        for (int i = 0; i < 32; ++i) s[(2 * i + kp) * 257 + n] = ok ? tv[i] : 0.f;
    }
    LDS_SYNC();
#pragma unroll
    for (int j = 0; j < 4; ++j) {
        const int q = tid + 512 * j, c = q & 7, n = q >> 3;
        const float* sp = s + (8 * c) * 257 + n;
        pg8::u32x4 o; o.x = pk2(sp[0], sp[257]); o.y = pk2(sp[2 * 257], sp[3 * 257]); o.z = pk2(sp[4 * 257], sp[5 * 257]); o.w = pk2(sp[6 * 257], sp[7 * 257]);
        *(pg8::u32x4*)(WT + (size_t)(n0 + n) * K + k0 + 8 * c) = o;
    }
    LDS_SYNC();
}
DEV void phase_prologue(const Params& P, unsigned char* lds) {
    const int tid = TID();
    float* s = (float*)lds;
    constexpr int I_IN = 16 * (ZW / 256), I_OUT = 16 * 4, I_1 = 16 * 16, I_2 = 64 * 4, I_L = I_IN + I_OUT + I_1 + I_2;
    for (int it = blockIdx.x; it < DEPTH * I_L; it += gridDim.x) {
        const int l = it / I_L; int r = it % I_L;
        if (r < I_IN) { transpose_item(INP(I_WIN) + (size_t)l * D * D_IN, D, D_IN, ZW, (bf16_t*)(P.ws + WS_WIN) + (size_t)l * ZW * D, r, s); continue; } r -= I_IN;
        if (r < I_OUT) { transpose_item(INP(I_WOUT) + (size_t)l * D * D, D, D, D, (bf16_t*)(P.ws + WS_WOUT) + (size_t)l * D * D, r, s); continue; } r -= I_OUT;
        if (r < I_1) { transpose_item(INP(I_W1) + (size_t)l * D * DFF, D, DFF, DFF, (bf16_t*)(P.ws + WS_W1) + (size_t)l * DFF * D, r, s); continue; } r -= I_1;
        transpose_item(INP(I_W2) + (size_t)l * DFF * D, DFF, D, D, (bf16_t*)(P.ws + WS_W2) + (size_t)l * D * DFF, r, s);
    }
    for (int e = blockIdx.x * 512 + tid; e < DEPTH * SW_LAYER; e += gridDim.x * 512) {
        const int l = e / SW_LAYER, q = e % SW_LAYER; float v;
        if (q < SW_AUP) { const int d = q >> 14, c = (q >> 6) & 255, j = q & 63; v = INP(I_WUP)[(((size_t)l * 2 + d) * 64 + j) * DG + c]; }
        else if (q < SW_GUP) { const int q2 = q - SW_AUP, d = q2 >> 14, c = (q2 >> 6) & 255, j = q2 & 63; v = INP(I_AUP)[(((size_t)l * 2 + d) * 64 + j) * DG + c]; }
        else if (q < SW_CPW) { const int q2 = q - SW_GUP, c = q2 >> 7, j = q2 & 127; v = INP(I_GUP)[((size_t)l * 128 + j) * DG + c]; }
        else if (q < SW_POOL) { const int q2 = q - SW_CPW, co = q2 >> 8, ci = q2 & 255; v = INP(I_CPW)[((size_t)l * DG + ci) * DG + co]; }
        else { const int q2 = q - SW_POOL, gi = q2 >> 12, o = (q2 >> 6) & 63, ci = q2 & 63; v = INP(I_POOLW)[(((size_t)l * 4 + gi) * 64 + ci) * 64 + o]; }
        ((bf16_t*)(P.ws + WS_SW))[e] = f2bf(v);
    }
    for (int it = blockIdx.x; it < DEPTH * 96; it += gridDim.x) {
        const int l = it / 96, n0 = (it % 96) * 64, n = tid & 63, kg = tid >> 6;
        LDS_SYNC();
        for (int e = tid; e < NMOD * 1024; e += 512) { const int j = e >> 10, k = e & 1023; const float cv = (j == 0) ? INP(I_CCTX)[k] : INP(I_C)[(size_t)(j - 1) * D + k]; s[e] = silu_(cv); }
        LDS_SYNC();
        const float* w = INP(I_WMOD) + ((size_t)l * D + kg * 128) * 6144 + n0 + n;
        float a[NMOD];
#pragma unroll
        for (int j = 0; j < NMOD; ++j) a[j] = 0.f;
#pragma unroll
        for (int kb = 0; kb < 4; ++kb) { float wv[32];
#pragma unroll
            for (int k = 0; k < 32; ++k) wv[k] = w[(size_t)(kb * 32 + k) * 6144];
#pragma unroll
            for (int k = 0; k < 32; ++k)
#pragma unroll
                for (int j = 0; j < NMOD; ++j) a[j] += s[j * 1024 + kg * 128 + kb * 32 + k] * wv[k]; }
        float* part = s + NMOD * 1024;
#pragma unroll
        for (int j = 0; j < NMOD; ++j) part[(kg * NMOD + j) * 64 + n] = a[j];
        LDS_SYNC();
        if (tid < NMOD * 64) { const int j = tid >> 6, nn = tid & 63; float t = INP(I_BMOD)[(size_t)l * 6144 + n0 + nn];
#pragma unroll
            for (int g = 0; g < 8; ++g) t += part[(g * NMOD + j) * 64 + nn];
            ((float*)(P.ws + WS_MOD))[((size_t)l * NMOD + j) * 6144 + n0 + nn] = t; }
    }
}

DEV void phase_norm(const Params& P, int l, int which  ) {
    const int tid = TID(), lane = tid & 63, wave = tid >> 6;
    const int gw = blockIdx.x * 8 + wave, NGW = gridDim.x * 8;
    const float* ng = INP(which ? I_N2G : I_N1G) + (size_t)l * D;
    const bool from_input = (l == 0 && which == 0);
    bf16_t* H = (bf16_t*)(P.ws + WS_H);
    for (int m0 = gw; m0 < M; m0 += 2 * NGW) {
        const int mm[2] = {m0, m0 + NGW < M ? m0 + NGW : m0};
        pg8::f32x4 v[2][4]; float ss[2] = {0.f, 0.f};
#pragma unroll
        for (int q = 0; q < 2; ++q) { const float* xr = xrow(P, from_input, mm[q]);
#pragma unroll
            for (int j = 0; j < 4; ++j) v[q][j] = *(const pg8::f32x4*)(xr + 4 * lane + 256 * j); }
#pragma unroll
        for (int q = 0; q < 2; ++q) {
#pragma unroll
            for (int j = 0; j < 4; ++j) ss[q] += (v[q][j][0] * v[q][j][0] + v[q][j][1] * v[q][j][1]) + (v[q][j][2] * v[q][j][2] + v[q][j][3] * v[q][j][3]);
            const float rs = frsq(wave_sum(ss[q]) * (1.f / D) + 1e-6f);
            const float* mv = mod_vec(P, l, mod_index(mm[q])) + which * 3072;
#pragma unroll
            for (int j = 0; j < 4; ++j) { const int c = 4 * lane + 256 * j;
                const pg8::f32x4 g = *(const pg8::f32x4*)(ng + c), sh = *(const pg8::f32x4*)(mv + c), sc = *(const pg8::f32x4*)(mv + 1024 + c);
                const pg8::f32x4 o = v[q][j] * rs * g * (sc + 1.f) + sh;
                unsigned long long w = (unsigned long long)pk2(o[0], o[1]) | ((unsigned long long)pk2(o[2], o[3]) << 32);
                *(unsigned long long*)(H + (size_t)mm[q] * D + c) = w; } }
    }
}
DEV void phase_final(const Params& P) {
    const int tid = TID(), lane = tid & 63, wave = tid >> 6;
    const int gw = blockIdx.x * 8 + wave, NGW = gridDim.x * 8;
    const float* ng = INP(I_FG);
    for (int m = gw; m < M; m += NGW) {
        float* xr = P.out + (size_t)m * D;
        pg8::f32x4 v[4]; float ss = 0.f;
#pragma unroll
        for (int j = 0; j < 4; ++j) { v[j] = *(const pg8::f32x4*)(xr + 4 * lane + 256 * j); ss += (v[j][0] * v[j][0] + v[j][1] * v[j][1]) + (v[j][2] * v[j][2] + v[j][3] * v[j][3]); }
        const float rs = frsq(wave_sum(ss) * (1.f / D) + 1e-6f);
#pragma unroll
        for (int j = 0; j < 4; ++j) { const int c = 4 * lane + 256 * j; *(pg8::f32x4*)(xr + c) = v[j] * rs * *(const pg8::f32x4*)(ng + c); }
    }
}

constexpr int ZS_LD = 1024 + 8;
DEV float zmix(const bf16_t* Zs, int row, int col, float mu) {
    const float z0 = bf2f(Zs[row * ZS_LD + col]); return z0 + (0.5f * (bf2f(Zs[(row - 1) * ZS_LD + col]) + bf2f(Zs[(row + 1) * ZS_LD + col])) - z0) * mu;
}
DEV void rwkv_prep_item(const Params& P, int l, int it, unsigned char* lds) {
    const int tid = TID(), lane = tid & 63, wave = tid >> 6, fr = lane & 15, fq = lane >> 4;
    const bf16_t* Z = (const bf16_t*)(P.ws + WS_Z);
    bf16_t* Zs = (bf16_t*)lds; bf16_t* LRw = (bf16_t*)(lds + 111616); bf16_t* LRa = LRw + 32 * 72; bf16_t* LRg = LRa + 32 * 72; float* inv = (float*)(LRg + 32 * 136);
    const bf16_t* SW = (const bf16_t*)(P.ws + WS_SW) + (size_t)l * SW_LAYER;
    const int m0 = it * 32; const SeqInfo s0 = seq_of(m0);
    LDS_SYNC();
#pragma unroll
    for (int r = 0; r < 9; ++r) { const int e = tid + 512 * r, row = e >> 7, ch = e & 127, t = s0.t - 1 + row, tc = t < 0 ? 0 : (t >= s0.T ? s0.T - 1 : t);
        if (e < 34 * 128) { pg8::u32x4 v = *(const pg8::u32x4*)(Z + (size_t)(s0.base + tc) * ZW + ch * 8); if (t != tc) v = (pg8::u32x4){0u, 0u, 0u, 0u};
            *(pg8::u32x4*)(Zs + row * ZS_LD + ch * 8) = v; } }
    LDS_SYNC();
    {
        const int c = tid & 255, tg = tid >> 8; const float* mu = INP(I_MU) + (size_t)l * 1024; const float mu_k = mu[256 + c], mu_l = mu[768 + c], k_k = INP(I_KK)[(size_t)l * DG + c];
#pragma unroll 4
        for (int tt = 0; tt < 16; ++tt) { const int tl = tg * 16 + tt;
            const float lo = zmix(Zs, tl + 1, 768 + c, mu_l);
            if (c < 64) LRw[tl * 72 + c] = f2bf(tanh_(lo)); else if (c < 128) LRa[tl * 72 + c - 64] = f2bf(lo); else LRg[tl * 136 + c - 128] = f2bf(sigm(lo));
            const float kk = zmix(Zs, tl + 1, 256 + c, mu_k) * k_k, ssq = wave_sum(kk * kk);
            if (lane == 0) inv[tl * 4 + (c >> 6)] = frsq(ssq + 1e-12f); }
    }
    LDS_SYNC();
    const int h = wave & 3, rt = wave >> 2;
    float rv[4][4], kv[4][4], kkv[4][4];
    {
        pg8::f32x4 ag[4];
#pragma unroll
        for (int ct = 0; ct < 4; ++ct) { ag[ct] = (pg8::f32x4){0.f, 0.f, 0.f, 0.f};
#pragma unroll
            for (int ks = 0; ks < 4; ++ks) ag[ct] = mfma16(*(const pg8::bf16x8*)(LRg + (16 * rt + fr) * 136 + ks * 32 + fq * 8), *(const pg8::bf16x8*)(SW + SW_GUP + (64 * h + 16 * ct + fr) * 128 + ks * 32 + fq * 8), ag[ct]); }
        const float* mu = INP(I_MU) + (size_t)l * 1024;
#pragma unroll
        for (int ct = 0; ct < 4; ++ct) { const int c = 64 * h + 16 * ct + fr; const float mu_r = mu[c], mu_k = mu[256 + c], mu_v = mu[512 + c], k_k = INP(I_KK)[(size_t)l * DG + c];
#pragma unroll
            for (int i = 0; i < 4; ++i) { const int tl = 16 * rt + 4 * fq + i; const size_t o = (size_t)(m0 + tl) * DG + c;
                const float r = zmix(Zs, tl + 1, c, mu_r), k = zmix(Zs, tl + 1, 256 + c, mu_k), v = zmix(Zs, tl + 1, 512 + c, mu_v), kk = k * k_k * inv[tl * 4 + h];
                rv[ct][i] = r; kv[ct][i] = k; kkv[ct][i] = kk;
                ((f16*)(P.ws + WS_RV))[o] = (f16)v; ((f16*)(P.ws + WS_RG))[o] = (f16)ag[ct][i]; } }
    }
    LDS_SYNC();
    {
        unsigned char* wl = lds + wave * 13952;
        f16* XA = (f16*)wl; f16* XR = XA + 16 * 68; f16* XB = XR + 16 * 68; f16* XK = XB + 16 * 68;
        float* Ew = (float*)(XK + 16 * 68); float* LAs = Ew + 16 * 64; float* bonW = LAs + 16 * 17;
        const int mc = m0 + 16 * rt;
        float kav[4], rkv[4];
        { const float* kap = INP(I_KA) + (size_t)l * DG + 64 * h + fr; const float* rkp = INP(I_RK) + (size_t)l * DG + 64 * h + fr;
#pragma unroll
          for (int ct = 0; ct < 4; ++ct) { kav[ct] = kap[16 * ct]; rkv[ct] = rkp[16 * ct]; } }
#pragma unroll 1
        for (int d = 0; d < 2; ++d) {
            unsigned char* rec = P.ws + WS_RCH + ((size_t)(d * 4 + h) * (M / 16) + mc / 16) * RCH_REC;
            float ev[4][4], kdv[4][4], bv[4][4], bp[4] = {0.f, 0.f, 0.f, 0.f};
            float w0v[4], a0v[4]; pg8::bf16x8 bw[4][2], ba[4][2];
            { const float* w0p = INP(I_W0) + ((size_t)l * 2 + d) * DG + 64 * h + fr; const float* a0p = INP(I_A0) + ((size_t)l * 2 + d) * DG + 64 * h + fr;
#pragma unroll
              for (int ct = 0; ct < 4; ++ct) { w0v[ct] = w0p[16 * ct]; a0v[ct] = a0p[16 * ct];
#pragma unroll
                  for (int ks = 0; ks < 2; ++ks) { const int bo = ((d * 256 + 64 * h + 16 * ct + fr) * 64) + ks * 32 + fq * 8; bw[ct][ks] = *(const pg8::bf16x8*)(SW + SW_WUP + bo); ba[ct][ks] = *(const pg8::bf16x8*)(SW + SW_AUP + bo); } } }
#pragma unroll
            for (int ct = 0; ct < 4; ++ct) {
                pg8::f32x4 aw = {0.f, 0.f, 0.f, 0.f}, aa = {0.f, 0.f, 0.f, 0.f};
#pragma unroll
                for (int ks = 0; ks < 2; ++ks) {
                    aw = mfma16(*(const pg8::bf16x8*)(LRw + (16 * rt + fr) * 72 + ks * 32 + fq * 8), bw[ct][ks], aw);
                    aa = mfma16(*(const pg8::bf16x8*)(LRa + (16 * rt + fr) * 72 + ks * 32 + fq * 8), ba[ct][ks], aa); }
                const float w0 = w0v[ct], a0 = a0v[ct], k_a = kav[ct], r_k = rkv[ct];
#pragma unroll
                for (int i = 0; i < 4; ++i) { const float e = fexp(-softplus_(-(w0 + aw[i])) - 0.5f), a = sigm(a0 + aa[i]);
                    ev[ct][i] = e; kdv[ct][i] = kv[ct][i] * (1.f + (a - 1.f) * k_a); bv[ct][i] = kkv[ct][i] * a; bp[i] += rv[ct][i] * kdv[ct][i] * r_k;
                    Ew[(4 * fq + i) * 64 + 16 * ct + fr] = e; } }
#pragma unroll
            for (int i = 0; i < 4; ++i) { const float bs = sum16(bp[i]); const int tok = 4 * fq + i; if (fr == 0) bonW[d ? 15 - tok : tok] = bs; }
            LDS_SYNC();
            {
                float cum = 0.f;
#pragma unroll
                for (int pos = 0; pos < 16; ++pos) { const int tok = d ? 15 - pos : pos; const float x = Ew[tok * 64 + lane]; Ew[tok * 64 + lane] = cum; cum += x; }
                ((float*)(rec + 10240))[lane] = fexp(-cum);
            }
            LDS_SYNC();
#pragma unroll
            for (int ct = 0; ct < 4; ++ct)
#pragma unroll
                for (int i = 0; i < 4; ++i) { const int tok = 4 * fq + i, k = 16 * ct + fr, pos = d ? 15 - tok : tok; const float cb = Ew[tok * 64 + k], e = ev[ct][i];
                    const float wm1 = fexp(-cb), iw = fexp(cb + e), wt = fexp(-(cb + e));
                    const f16 al = (f16)(kkv[ct][i] * wm1), rh = (f16)(rv[ct][i] * wt), be = (f16)(bv[ct][i] * iw), ka = (f16)(kdv[ct][i] * iw);
                    XA[pos * 68 + k] = al; XR[pos * 68 + k] = rh; XB[pos * 68 + k] = be; XK[pos * 68 + k] = ka; }
            LDS_SYNC();
            {
                typedef unsigned long long u64; const int pos = lane >> 2;
#pragma unroll
                for (int gg = 0; gg < 2; ++gg) { const int g = 2 * (lane & 3) + gg, go = pos * 128 + (((g ^ (pos >> 1)) & 7) << 4);
                    const u64 a0 = *(const u64*)(XA + pos * 68 + 8 * g), a1 = *(const u64*)(XA + pos * 68 + 8 * g + 4), r0 = *(const u64*)(XR + pos * 68 + 8 * g), r1 = *(const u64*)(XR + pos * 68 + 8 * g + 4);
                    pg8::u32x4 va, vr; va.x = (unsigned)a0; va.y = (unsigned)(a0 >> 32); va.z = (unsigned)a1; va.w = (unsigned)(a1 >> 32); vr.x = (unsigned)r0; vr.y = (unsigned)(r0 >> 32); vr.z = (unsigned)r1; vr.w = (unsigned)(r1 >> 32);
                    *(pg8::u32x4*)(rec + go) = va; *(pg8::u32x4*)(rec + 2048 + go) = vr; }
            }
            {
                typedef f16 h8v __attribute__((ext_vector_type(8)));
                h8v b0, b1, k0, k1;
#pragma unroll
                for (int sx = 0; sx < 8; ++sx) { b0[sx] = XB[sx * 68 + lane]; b1[sx] = XB[(8 + sx) * 68 + lane]; k0[sx] = XK[sx * 68 + lane]; k1[sx] = XK[(8 + sx) * 68 + lane]; }
                { const int sw = ((lane >> 3) & 1) * 16; *(h8v*)(rec + 4096 + lane * 32 + sw) = b0; *(h8v*)(rec + 4096 + lane * 32 + (sw ^ 16)) = b1; *(h8v*)(rec + 6144 + lane * 32 + sw) = k0; *(h8v*)(rec + 6144 + lane * 32 + (sw ^ 16)) = k1; }
            }
            {
                pg8::f32x4 la = {0.f, 0.f, 0.f, 0.f}, lb = la, ma = la, mb = la;
#pragma unroll
                for (int j = 0; j < 4; ++j) { const h4 xa = *(const h4*)(XA + fr * 68 + 16 * j + 4 * fq), xr = *(const h4*)(XR + fr * 68 + 16 * j + 4 * fq), xb = *(const h4*)(XB + fr * 68 + 16 * j + 4 * fq), xk = *(const h4*)(XK + fr * 68 + 16 * j + 4 * fq);
                    la = mfma16h(xa, xb, la); lb = mfma16h(xa, xk, lb); ma = mfma16h(xr, xb, ma); mb = mfma16h(xr, xk, mb); }
#pragma unroll
                for (int i = 0; i < 4; ++i) { const int t = 4 * fq + i, sx = fr;
                    LAs[t * 17 + sx] = sx < t ? la[i] : 0.f;
                    const int mo = t * 16 + ((((sx >> 3) ^ (t >> 3)) & 1) << 3) + (sx & 7);
                    ((f16*)(rec + 8192))[mo] = (f16)(sx < t ? lb[i] : 0.f);
                    ((f16*)(rec + 9216))[mo] = (f16)(sx <= t ? ma[i] : 0.f);
                    ((f16*)(rec + 9728))[mo] = (f16)((sx <= t ? mb[i] : 0.f) + (sx == t ? bonW[t] : 0.f)); }
            }
            LDS_SYNC();
            {
                const int col = lane & 15; float tc[16];
#pragma unroll
                for (int t = 0; t < 16; ++t) { float x = (t == col) ? 1.f : 0.f;
#pragma unroll
                    for (int sx = 0; sx < t; ++sx) x -= LAs[t * 17 + sx] * tc[sx];
                    tc[t] = x; }
                if (lane < 16) {
#pragma unroll
                    for (int t = 0; t < 16; ++t) ((f16*)(rec + 8704))[t * 16 + ((((col >> 3) ^ (t >> 3)) & 1) << 3) + (col & 7)] = (f16)(-tc[t]); }
            }
            LDS_SYNC();
        }
    }
}
DEV void phase_rwkv_prep(const Params& P, int l, unsigned char* lds) { for (int it = blockIdx.x; it < M / 32; it += gridDim.x) rwkv_prep_item(P, l, it, lds); }

constexpr int CS_STAGE = 4 * RCH_REC + 4 * 2048;
struct CsEarly { h4 al[4], rh[4], lb, vop; };
struct CsLate { h4 bt[4], kt[4], nt, ma, mb; pg8::f32x4 wc[4]; };
DEV CsEarly cs_load_early(const unsigned char* im, const unsigned char* vim, int fr, int fq, int vcol2, int d) {
    CsEarly o; const int h8 = 8 * (fq & 1), mx = (((fq >> 1) ^ (fr >> 3)) & 1) << 4;
#pragma unroll
    for (int j = 0; j < 4; ++j) { const int go = fr * 128 + ((((2 * j + (fq >> 1)) ^ (fr >> 1)) & 7) << 4) + h8; o.al[j] = *(const h4*)(im + go); o.rh[j] = *(const h4*)(im + 2048 + go); }
    o.lb = *(const h4*)(im + 8192 + fr * 32 + mx + h8);
#pragma unroll
    for (int jj = 0; jj < 4; ++jj) { const int sx = 4 * fq + jj, tok = d ? 15 - sx : sx; o.vop[jj] = *(const f16*)(vim + tok * 128 + vcol2); }
    return o;
}
DEV CsLate cs_load_late(const unsigned char* im, int fr, int fq) {
    CsLate o; const int h8 = 8 * (fq & 1), mx = (((fq >> 1) ^ (fr >> 3)) & 1) << 4;
#pragma unroll
    for (int j = 0; j < 4; ++j) { o.bt[j] = *(const h4*)(im + 4096 + (16 * j + fr) * 32 + mx + h8); o.kt[j] = *(const h4*)(im + 6144 + (16 * j + fr) * 32 + mx + h8); o.wc[j] = *(const pg8::f32x4*)(im + 10240 + (16 * j + 4 * fq) * 4); }
    o.nt = *(const h4*)(im + 8704 + fr * 32 + mx + h8); o.ma = *(const h4*)(im + 9216 + fr * 32 + mx + h8); o.mb = *(const h4*)(im + 9728 + fr * 32 + mx + h8);
    return o;
}
#ifdef CPU_EMU
#define SCHED_FENCE()
#define WAVE_UNIFORM(x) (x)
#else
#define SCHED_FENCE() __builtin_amdgcn_sched_barrier(0)
#define WAVE_UNIFORM(x) __builtin_amdgcn_readfirstlane(x)
#endif
DEV void rwkv_chunk_scan_item(const Params& P, int l, int chain, unsigned char* lds) {
    const int tid = TID(), lane = tid & 63, wave = WAVE_UNIFORM(tid >> 6), fr = lane & 15, fq = lane >> 4;
    const int d = chain & 1, h = (chain >> 1) & 3, sq = chain >> 3;
    const bool lat = sq >= BATCH;
    const int T = lat ? DEC_SEQ : SEQ, base = lat ? M_CTX + (sq - BATCH) * DEC_SEQ : sq * SEQ;
    const unsigned char* RCH = P.ws + WS_RCH + (size_t)(d * 4 + h) * (M / 16) * RCH_REC;
    const unsigned char* RVb = P.ws + WS_RV + (size_t)h * 128;
    f16* RY = (f16*)(P.ws + WS_RY) + (size_t)d * M * DG;
    const bool scanner = wave < 4; const int vs = 16 * wave;
    pg8::f32x4 S[4];
    if (scanner && lat) { const float* si = INP(I_SRWKV) + ((((size_t)(sq - BATCH) * DEPTH + l) * 2 + d) * 4 + h) * 4096 + (size_t)(vs + fr) * 64 + 4 * fq;
#pragma unroll
        for (int j = 0; j < 4; ++j) S[j] = *(const pg8::f32x4*)(si + 16 * j); }
    else {
#pragma unroll
        for (int j = 0; j < 4; ++j) S[j] = (pg8::f32x4){0.f, 0.f, 0.f, 0.f}; }
    const int lt = tid - 256;
    pg8::u32x4 gA[13], gB[13];
#define CS_GLOAD(G_, st) do { const int c0_ = d ? (T / 16 - 4 - 4 * (st)) : 4 * (st); const unsigned char* rs_ = RCH + (size_t)(base / 16 + c0_) * RCH_REC + lt * 16; \
        _Pragma("unroll") for (int r_ = 0; r_ < 11; ++r_) if (r_ < 10 || lt < 64) G_[r_] = *(const pg8::u32x4*)(rs_ + r_ * 4096); \
        const unsigned char* vs_ = RVb + (size_t)(base + 16 * c0_ + (lt >> 3)) * 512 + (lt & 7) * 16; \
        G_[11] = *(const pg8::u32x4*)vs_; G_[12] = *(const pg8::u32x4*)(vs_ + 32 * 512); } while (0)
#define CS_LSTORE(G_, bb) do { unsigned char* ld_ = lds + (bb) * CS_STAGE + lt * 16; \
        _Pragma("unroll") for (int r_ = 0; r_ < 11; ++r_) if (r_ < 10 || lt < 64) *(pg8::u32x4*)(ld_ + r_ * 4096) = G_[r_]; \
        *(pg8::u32x4*)(ld_ + 4 * RCH_REC) = G_[11]; *(pg8::u32x4*)(ld_ + 4 * RCH_REC + 4096) = G_[12]; } while (0)
#define CS_COMPUTE(st) do { { const unsigned char* im0 = lds + ((st) & 1) * CS_STAGE; \
            const unsigned char* vm0 = im0 + 4 * RCH_REC; \
            CsEarly cur = cs_load_early(im0 + (d ? 3 : 0) * RCH_REC, vm0 + (d ? 3 : 0) * 2048, fr, fq, (vs + fr) * 2, d); \
            _Pragma("unroll") for (int q = 0; q < 4; ++q) { \
                const CsLate lt_ = cs_load_late(im0 + (d ? 3 - q : q) * RCH_REC, fr, fq); \
                CsEarly nxt = cur; if (q < 3) nxt = cs_load_early(im0 + (d ? 2 - q : q + 1) * RCH_REC, vm0 + (d ? 2 - q : q + 1) * 2048, fr, fq, (vs + fr) * 2, d); \
                SCHED_FENCE(); \
                const int ck = d ? (T / 16 - 1 - (4 * (st) + q)) : 4 * (st) + q; \
                h4 s16[4]; \
                _Pragma("unroll") for (int j = 0; j < 4; ++j) s16[j] = cvt_h4(S[j]); \
                pg8::f32x4 dd = {0.f, 0.f, 0.f, 0.f}, yy = {0.f, 0.f, 0.f, 0.f}; \
                _Pragma("unroll") for (int j = 0; j < 4; ++j) dd = mfma16h(cur.al[j], s16[j], dd); \
                dd = mfma16h(cur.lb, cur.vop, dd); \
                _Pragma("unroll") for (int j = 0; j < 4; ++j) yy = mfma16h(cur.rh[j], s16[j], yy); \
                yy = mfma16h(lt_.mb, cur.vop, yy); \
                const h4 e16 = cvt_h4(dd); \
                const pg8::f32x4 pp = mfma16h(lt_.nt, e16, (pg8::f32x4){0.f, 0.f, 0.f, 0.f}); \
                _Pragma("unroll") for (int j = 0; j < 4; ++j) S[j] = mfma16h(lt_.kt[j], cur.vop, S[j]); \
                const h4 p16 = cvt_h4(pp); \
                _Pragma("unroll") for (int j = 0; j < 4; ++j) S[j] = mfma16h(lt_.bt[j], p16, S[j]); \
                yy = mfma16h(lt_.ma, p16, yy); \
                _Pragma("unroll") for (int j = 0; j < 4; ++j) S[j] = S[j] * lt_.wc[j]; \
                f16* yp_ = RY + (size_t)(base + 16 * ck) * DG + h * 64 + vs + fr; \
                _Pragma("unroll") for (int i = 0; i < 4; ++i) { const int sx = 4 * fq + i, tok = d ? 15 - sx : sx; yp_[tok * DG] = (f16)yy[i]; } \
                cur = nxt; \
            } } } while (0)
    const int nst = T / 64;
    LDS_SYNC();
    if (!scanner) {
        CS_GLOAD(gA, 0); CS_LSTORE(gA, 0); if (nst > 1) CS_GLOAD(gB, 1); if (nst > 2) CS_GLOAD(gA, 2);
        LDS_SYNC();
        for (int st = 0; st < nst; st += 2) {
            if (st + 1 < nst) CS_LSTORE(gB, 1);
            if (st + 3 < nst) CS_GLOAD(gB, st + 3);
            LDS_SYNC();
            if (st + 1 >= nst) break;
            if (st + 2 < nst) CS_LSTORE(gA, 0);
            if (st + 4 < nst) CS_GLOAD(gA, st + 4);
            LDS_SYNC();
        }
    } else {
        LDS_SYNC();
        for (int st = 0; st < nst; ++st) { CS_COMPUTE(st); LDS_SYNC(); }
    }
#undef CS_GLOAD
#undef CS_LSTORE
#undef CS_COMPUTE
    if (!lat && scanner) { float* so = P.out + (size_t)M * D + ((((size_t)sq * DEPTH + l) * 2 + d) * 4 + h) * 4096 + (size_t)(vs + fr) * 64 + 4 * fq;
#pragma unroll
        for (int j = 0; j < 4; ++j) *(pg8::f32x4*)(so + 16 * j) = S[j]; }
}

DEV void unpack8(pg8::u32x4 v, float (&o)[8]) {
#pragma unroll
    for (int j = 0; j < 4; ++j) { o[2 * j] = __builtin_bit_cast(float, v[j] << 16); o[2 * j + 1] = __builtin_bit_cast(float, v[j] & 0xffff0000u); }
}
DEV void mlstm_load_kv(const Params& P, int l, const bf16_t* Z, const SeqInfo& s0, int h, bf16_t* Qs, bf16_t* Ks, bf16_t* KTs, bf16_t* VTs, int tid) {
    const float* cw = INP(I_QKCONV) + (size_t)l * 3 * 512;
    const int i = tid >> 3, c8 = (tid & 7) * 8, t = s0.t + i;
    pg8::u32x4 zq[3], zk[3]; float msk[3];
#pragma unroll
    for (int j = 0; j < 3; ++j) { const int tt = t + j - 1, tc = tt < 0 ? 0 : (tt >= s0.T ? s0.T - 1 : tt); msk[j] = (tt >= 0 && tt < s0.T) ? 1.f : 0.f;
        const bf16_t* zr = Z + ((size_t)s0.base + tc) * ZW + ZD + h * 64 + c8; if (Qs) zq[j] = *(const pg8::u32x4*)zr; zk[j] = *(const pg8::u32x4*)(zr + 256); }
    const pg8::u32x4 zv = *(const pg8::u32x4*)(Z + ((size_t)s0.base + t) * ZW + ZD_V + h * 64 + c8);
    float aq[8], ak[8];
#pragma unroll
    for (int e = 0; e < 8; ++e) { aq[e] = 0.f; ak[e] = 0.f; }
#pragma unroll
    for (int j = 0; j < 3; ++j) { float xq[8], xk[8]; if (Qs) unpack8(zq[j], xq); unpack8(zk[j], xk);
        const float* wq = cw + j * 512 + h * 64 + c8; const pg8::f32x4 wk0 = *(const pg8::f32x4*)(wq + 256), wk1 = *(const pg8::f32x4*)(wq + 260);
#pragma unroll
        for (int e = 0; e < 8; ++e) ak[e] += xk[e] * (e < 4 ? wk0[e] : wk1[e - 4]) * msk[j];
        if (Qs) { const pg8::f32x4 wq0 = *(const pg8::f32x4*)wq, wq1 = *(const pg8::f32x4*)(wq + 4);
#pragma unroll
            for (int e = 0; e < 8; ++e) aq[e] += xq[e] * (e < 4 ? wq0[e] : wq1[e - 4]) * msk[j]; } }
    pg8::u32x4 kb;
#pragma unroll
    for (int e = 0; e < 4; ++e) kb[e] = pk2(silu_(ak[2 * e]) * 0.125f, silu_(ak[2 * e + 1]) * 0.125f);
    if (Qs) { pg8::u32x4 qb;
#pragma unroll
        for (int e = 0; e < 4; ++e) qb[e] = pk2(silu_(aq[2 * e]), silu_(aq[2 * e + 1]));
        *(pg8::u32x4*)(Qs + i * LT + c8) = qb; *(pg8::u32x4*)(Ks + i * LT + c8) = kb; }
#pragma unroll
    for (int e = 0; e < 8; ++e) { const bf16_t kv = (bf16_t)(kb[e >> 1] >> (16 * (e & 1))), vv = (bf16_t)(zv[e >> 1] >> (16 * (e & 1)));
        if (KTs) KTs[(c8 + e) * LT + i] = kv;
        VTs[(c8 + e) * LT + i] = vv; }
}
DEV void mlstm_local_item(const Params& P, int l, int it, unsigned char* lds) {
    const int tid = TID(), lane = tid & 63, wave = tid >> 6, fr = lane & 15, fq = lane >> 4;
    const int tcg = it >> 2, h = it & 3, m0 = tcg * 64; const SeqInfo s0 = seq_of(m0);
    const bf16_t* Z = (const bf16_t*)(P.ws + WS_Z);
    bf16_t* KTs = (bf16_t*)lds; bf16_t* VTs = KTs + 64 * LT; bf16_t* VWs = VTs + 64 * LT;
    float* li = (float*)(VWs + 2 * 64 * LT); float* lf = li + 128; float* wend = lf + 128;
    LDS_SYNC();
    mlstm_load_kv(P, l, Z, s0, h, nullptr, nullptr, KTs, VTs, tid);
    if (tid < 128) { const int d = tid >> 6, i = tid & 63; const size_t m = (size_t)m0 + i;
        li[tid] = bf2f(Z[m * ZW + ZD_I + d * 4 + h]) + INP(I_IB)[(size_t)l * 8 + d * 4 + h]; lf[tid] = -softplus_(-(bf2f(Z[m * ZW + ZD_F + d * 4 + h]) + INP(I_FB)[(size_t)l * 8 + d * 4 + h])); }
    LDS_SYNC();
    if (wave < 2) { const int d = wave, tok = d ? 63 - lane : lane;
        const float b = wave_incl_sum(lf[d * 64 + tok], lane), a = li[d * 64 + tok] - b;
        const float amax = lane_get(wave_incl_max(a, lane), 63), btot = lane_get(b, 63);
        wend[d * 64 + tok] = fexp(a - amax);
        if (lane == 0) { float* ab = (float*)(P.ws + WS_AB) + (((size_t)d * NTC + tcg) * 4 + h) * 2; ab[0] = btot + amax; ab[1] = btot; } }
    LDS_SYNC();
#pragma unroll
    for (int r = 0; r < 16; ++r) { const int e = tid + 512 * r, d = e >> 12, v = (e >> 6) & 63, sx = e & 63; VWs[(d * 64 + v) * LT + sx] = f2bf(wend[d * 64 + sx] * bf2f(VTs[v * LT + sx])); }
    if (tid < 128) { const int d = tid >> 6, k = tid & 63; float a = 0.f; for (int sx = 0; sx < 64; ++sx) a += wend[d * 64 + sx] * bf2f(KTs[k * LT + sx]);
        ((float*)(P.ws + WS_NU))[(((size_t)d * NTC + tcg) * 4 + h) * 64 + k] = a; }
    LDS_SYNC();
    {
        const int d = wave >> 2, tr = wave & 3; f16* up = (f16*)(P.ws + WS_UP) + (((size_t)d * NTC + tcg) * 4 + h) * 4096;
#pragma unroll
        for (int tc = 0; tc < 4; ++tc) { const pg8::f32x4 acc = tile_mm64(VWs + d * 64 * LT, 16 * tr, KTs, 16 * tc, fr, fq);
#pragma unroll
            for (int i = 0; i < 4; ++i) up[(16 * tr + 4 * fq + i) * 64 + 16 * tc + fr] = (f16)acc[i]; }
    }
}
typedef f16 h8 __attribute__((ext_vector_type(8)));
DEV void mlstm_state_item(const Params& P, int l, int chain, unsigned char* lds) {
    const int tid = TID();
    const int d = chain & 1, h = (chain >> 1) & 3, sq = chain >> 3;
    const bool lat = sq >= BATCH;
    const int T = lat ? DEC_SEQ : SEQ, base = lat ? M_CTX + (sq - BATCH) * DEC_SEQ : sq * SEQ, nc = T / 64, tc0 = base / 64;
    float C[8], n = 0.f, m = 0.f;
    if (lat) { const size_t sb = ((((size_t)(sq - BATCH) * DEPTH + l) * 2 + d) * 4 + h); const float* c0 = INP(I_SC) + sb * 4096 + tid * 8;
#pragma unroll
        for (int j = 0; j < 8; ++j) C[j] = c0[j];
        if (tid < 64) n = INP(I_SN)[sb * 64 + tid];
        m = INP(I_SM)[sb]; }
    else {
#pragma unroll
        for (int j = 0; j < 8; ++j) C[j] = 0.f; }
    const f16* UP = (const f16*)(P.ws + WS_UP); f16* CP = (f16*)(P.ws + WS_CP);
    const float* NU = (const float*)(P.ws + WS_NU); float* NP = (float*)(P.ws + WS_NP); const float* AB = (const float*)(P.ws + WS_AB); float* MP = (float*)(P.ws + WS_MP);
    size_t ix = ((size_t)d * NTC + tc0 + (d ? nc - 1 : 0)) * 4 + h; const long dix = d ? -4 : 4;
    h8 u = *(const h8*)(UP + ix * 4096 + tid * 8); float nu = tid < 64 ? NU[ix * 64 + tid] : 0.f; float ac = AB[ix * 2], bc = AB[ix * 2 + 1];
    for (int ci = 0; ci < nc; ++ci) {
        const size_t cx = ix; const h8 uc = u; const float nuc = nu, acc_ = ac, bcc = bc;
        if (ci + 1 < nc) { ix += dix; u = *(const h8*)(UP + ix * 4096 + tid * 8); nu = tid < 64 ? NU[ix * 64 + tid] : 0.f; ac = AB[ix * 2]; bc = AB[ix * 2 + 1]; }
        h8 cp;
#pragma unroll
        for (int j = 0; j < 8; ++j) cp[j] = (f16)C[j];
        *(h8*)(CP + cx * 4096 + tid * 8) = cp;
        if (tid < 64) NP[cx * 64 + tid] = n;
        if (tid == 0) MP[cx] = m;
        const float mn = fmaxf(m + bcc, acc_), cd = fexp(m + bcc - mn), cu = fexp(acc_ - mn);
#pragma unroll
        for (int j = 0; j < 8; ++j) C[j] = cd * C[j] + cu * (float)uc[j];
        n = cd * n + cu * nuc; m = mn;
    }
    if (!lat) {
        const size_t sb = ((((size_t)sq * DEPTH + l) * 2 + d) * 4 + h);
        float* oc = P.out + (size_t)M * D + (size_t)BATCH * DEPTH * 8 * 4096 + sb * 4096 + tid * 8;
#pragma unroll
        for (int j = 0; j < 8; ++j) oc[j] = C[j];
        if (tid < 64) P.out[(size_t)M * D + (size_t)2 * BATCH * DEPTH * 8 * 4096 + sb * 64 + tid] = n;
        if (tid == 0) P.out[(size_t)M * D + (size_t)2 * BATCH * DEPTH * 8 * 4096 + (size_t)BATCH * DEPTH * 8 * 64 + sb] = m;
    }
}
DEV void mlstm_out_item(const Params& P, int l, int it, unsigned char* lds) {
    const int tid = TID(), lane = tid & 63, wave = tid >> 6, fr = lane & 15, fq = lane >> 4;
    const int tcg = it >> 2, h = it & 3, m0 = tcg * 64; const SeqInfo s0 = seq_of(m0);
    const bf16_t* Z = (const bf16_t*)(P.ws + WS_Z);
    bf16_t* Y = (bf16_t*)(P.ws + WS_H);
    bf16_t* Qs = (bf16_t*)lds; bf16_t* Ks = Qs + 64 * LT; bf16_t* VTs = Ks + 64 * LT; bf16_t* Ss = VTs + 64 * LT; bf16_t* Cs = Ss + 2 * 64 * LT;
    float* li = (float*)(Cs + 2 * 64 * LT); float* lf = li + 128; float* bc = lf + 128; float* ml = bc + 128; float* e1 = ml + 128; float* e2 = e1 + 128; float* fl = e2 + 128; float* np = fl + 128;
    float* mp = np + 128; float* Hs = mp + 4;
    LDS_SYNC();
    mlstm_load_kv(P, l, Z, s0, h, Qs, Ks, nullptr, VTs, tid);
    if (tid < 128) { const int d = tid >> 6, i = tid & 63; const size_t m = (size_t)m0 + i;
        li[tid] = bf2f(Z[m * ZW + ZD_I + d * 4 + h]) + INP(I_IB)[(size_t)l * 8 + d * 4 + h]; lf[tid] = -softplus_(-(bf2f(Z[m * ZW + ZD_F + d * 4 + h]) + INP(I_FB)[(size_t)l * 8 + d * 4 + h]));
        np[tid] = ((const float*)(P.ws + WS_NP))[(((size_t)d * NTC + tcg) * 4 + h) * 64 + i]; }
    if (tid < 2) mp[tid] = ((const float*)(P.ws + WS_MP))[((size_t)tid * NTC + tcg) * 4 + h];
#pragma unroll
    for (int r = 0; r < 2; ++r) { const int e = (tid + 512 * r) * 8, d = e >> 12, v = (e >> 6) & 63, k = e & 63;
        const h8 c = *(const h8*)((const f16*)(P.ws + WS_CP) + (((size_t)d * NTC + tcg) * 4 + h) * 4096 + (e & 4095));
        pg8::u32x4 w; w.x = pk2((float)c[0], (float)c[1]); w.y = pk2((float)c[2], (float)c[3]); w.z = pk2((float)c[4], (float)c[5]); w.w = pk2((float)c[6], (float)c[7]);
        *(pg8::u32x4*)(Cs + (d * 64 + v) * LT + k) = w; }
    LDS_SYNC();
    if (wave < 2) { const int d = wave, x = d * 64 + (d ? 63 - lane : lane); const float m_prev = mp[d];
        const float b = wave_incl_sum(lf[x], lane), run = wave_incl_max(li[x] - b, lane), mloc = b + run, mt = fmaxf(b + m_prev, mloc);
        bc[x] = b; ml[x] = mloc; e1[x] = fexp(mloc - mt); e2[x] = fexp(b + m_prev - mt); fl[x] = fexp(-mt); }
    LDS_SYNC();
    {
        const int tr = wave >> 1;
#pragma unroll
        for (int cc = 0; cc < 2; ++cc) { const int tc = 2 * (wave & 1) + cc; const pg8::f32x4 acc = tile_mm64(Qs, 16 * tr, Ks, 16 * tc, fr, fq); const int sx = 16 * tc + fr;
#pragma unroll
            for (int i = 0; i < 4; ++i) { const int t = 16 * tr + 4 * fq + i;
#pragma unroll
                for (int d = 0; d < 2; ++d) { const bool ok = d ? sx >= t : sx <= t; const float w = ok ? fexp(bc[d * 64 + t] - bc[d * 64 + sx] + li[d * 64 + sx] - ml[d * 64 + t]) : 0.f;
                    Ss[(d * 64 + t) * LT + sx] = f2bf(acc[i] * w); } } }
    }
    LDS_SYNC();
    const int d = wave >> 2, tr = wave & 3;
    float hreg[4][4];
    {
        float den[4], nq[4];
#pragma unroll
        for (int i = 0; i < 4; ++i) { const int t = 16 * tr + 4 * fq + i; float a = 0.f, b = 0.f;
#pragma unroll
            for (int j = 0; j < 4; ++j) { a += bf2f(Ss[(d * 64 + t) * LT + fr * 4 + j]); b += np[d * 64 + fr * 4 + j] * bf2f(Qs[t * LT + fr * 4 + j]); }
            den[i] = sum16(a); nq[i] = sum16(b); }
#pragma unroll
        for (int tc = 0; tc < 4; ++tc) { const pg8::f32x4 num = tile_mm64(Ss + d * 64 * LT, 16 * tr, VTs, 16 * tc, fr, fq), cq = tile_mm64(Qs, 16 * tr, Cs + d * 64 * LT, 16 * tc, fr, fq);
#pragma unroll
            for (int i = 0; i < 4; ++i) { const int x = d * 64 + 16 * tr + 4 * fq + i; const float dn = fmaxf(fabsf(e1[x] * den[i] + e2[x] * nq[i]), fl[x]);
                hreg[tc][i] = (e1[x] * num[i] + e2[x] * cq[i]) / dn; } }
    }
    if (d == 1) {
#pragma unroll
        for (int tc = 0; tc < 4; ++tc)
#pragma unroll
            for (int i = 0; i < 4; ++i) Hs[(16 * tr + 4 * fq + i) * 65 + 16 * tc + fr] = hreg[tc][i]; }
    LDS_SYNC();
    if (d == 0) {
        float ss[4] = {0.f, 0.f, 0.f, 0.f};
#pragma unroll
        for (int tc = 0; tc < 4; ++tc)
#pragma unroll
            for (int i = 0; i < 4; ++i) { const int t = 16 * tr + 4 * fq + i, v = 16 * tc + fr; const float op = bf2f(Z[(size_t)(m0 + t) * ZW + ZD_O + h * 64 + v]);
                const float x = (hreg[tc][i] + Hs[t * 65 + v]) * sigm(op); hreg[tc][i] = x; ss[i] += x * x; }
#pragma unroll
        for (int i = 0; i < 4; ++i) ss[i] = frsq(sum16(ss[i]) * (1.f / 64.f) + 1e-6f);
#pragma unroll
        for (int tc = 0; tc < 4; ++tc) { const float g = INP(I_HNG)[(size_t)l * DG + h * 64 + 16 * tc + fr];
#pragma unroll
            for (int i = 0; i < 4; ++i) Y[(size_t)(m0 + 16 * tr + 4 * fq + i) * D + 768 + h * 64 + 16 * tc + fr] = f2bf(hreg[tc][i] * ss[i] * g); }
    }
}

DEV void conv_item(const Params& P, int l, int it, unsigned char* lds) {
    const int tid = TID(), c = tid & 255, tg = tid >> 8, lane = tid & 63, wave = tid >> 6, fr = lane & 15, fq = lane >> 4;
    const bf16_t* Z = (const bf16_t*)(P.ws + WS_Z);
    bf16_t* Y = (bf16_t*)(P.ws + WS_H);
    float* u = (float*)lds;
    float* cv = u + 62 * 256;
    float* st = cv + 32 * 256;
    bf16_t* As = (bf16_t*)lds;
    const int m0 = it * 32; const SeqInfo s0 = seq_of(m0);
    LDS_SYNC();
#pragma unroll
    for (int r = 0; r < 4; ++r) { const int e = tid + 512 * r, rr = e >> 5, c8 = (e & 31) * 8, t = s0.t - 15 + rr, tc = t < 0 ? 0 : (t >= s0.T ? s0.T - 1 : t);
        if (e >= 62 * 32) continue;
        pg8::f32x4 o0 = {0.f, 0.f, 0.f, 0.f}, o1 = {0.f, 0.f, 0.f, 0.f};
        const bf16_t* zr = Z + (size_t)(s0.base + tc) * ZW + ZC + c8; const pg8::u32x4 va = *(const pg8::u32x4*)zr, ga = *(const pg8::u32x4*)(zr + 256);
        if (t == tc) {
#pragma unroll
            for (int j = 0; j < 4; ++j) { const float v0 = __builtin_bit_cast(float, va[j] << 16), v1 = __builtin_bit_cast(float, va[j] & 0xffff0000u), g0 = __builtin_bit_cast(float, ga[j] << 16), g1 = __builtin_bit_cast(float, ga[j] & 0xffff0000u);
                const float a = v0 * sigm(g0), b = v1 * sigm(g1); if (j < 2) { o0[2 * j] = a; o0[2 * j + 1] = b; } else { o1[2 * j - 4] = a; o1[2 * j - 3] = b; } } }
        *(pg8::f32x4*)(u + rr * 256 + c8) = o0; *(pg8::f32x4*)(u + rr * 256 + c8 + 4) = o1; }
    LDS_SYNC();
    {
        float dw[31];
#pragma unroll
        for (int j = 0; j < 31; ++j) dw[j] = INP(I_CDW)[((size_t)l * 31 + j) * DG + c];
        const float cb = INP(I_CB)[(size_t)l * DG + c];
#pragma unroll 4
        for (int tt = 0; tt < 16; ++tt) { const int tl = tg * 16 + tt; float a = cb;
#pragma unroll
            for (int j = 0; j < 31; ++j) a += u[(tl + j) * 256 + c] * dw[j];
            cv[tl * 256 + c] = a; }
    }
    LDS_SYNC();
#pragma unroll
    for (int r = 0; r < 4; ++r) { const int tl = wave * 4 + r; float x[4]; float sm = 0.f;
#pragma unroll
        for (int j = 0; j < 4; ++j) { x[j] = cv[tl * 256 + lane + 64 * j]; sm += x[j]; }
        const float mean = wave_sum(sm) * (1.f / 256.f); float q2 = 0.f;
#pragma unroll
        for (int j = 0; j < 4; ++j) { const float dd = x[j] - mean; q2 += dd * dd; }
        const float var = wave_sum(q2) * (1.f / 256.f);
        if (lane == 0) { st[tl * 2] = mean; st[tl * 2 + 1] = frsq(var + 1e-5f); } }
    LDS_SYNC();
    {
        const float lg = INP(I_CLNG)[(size_t)l * DG + c], lb = INP(I_CLNB)[(size_t)l * DG + c];
#pragma unroll
        for (int tt = 0; tt < 16; ++tt) { const int tl = tg * 16 + tt; As[tl * 264 + c] = f2bf(silu_((cv[tl * 256 + c] - st[tl * 2]) * st[tl * 2 + 1] * lg + lb)); }
    }
    LDS_SYNC();
    {
        const bf16_t* BT = (const bf16_t*)(P.ws + WS_SW) + (size_t)l * SW_LAYER + SW_CPW;
        pg8::f32x4 acc[2][2];
#pragma unroll
        for (int rt = 0; rt < 2; ++rt)
#pragma unroll
            for (int cc = 0; cc < 2; ++cc) acc[rt][cc] = (pg8::f32x4){0.f, 0.f, 0.f, 0.f};
#pragma unroll
        for (int ks = 0; ks < 8; ++ks) { pg8::bf16x8 a[2], b[2];
#pragma unroll
            for (int rt = 0; rt < 2; ++rt) a[rt] = *(const pg8::bf16x8*)(As + (16 * rt + fr) * 264 + ks * 32 + fq * 8);
#pragma unroll
            for (int cc = 0; cc < 2; ++cc) b[cc] = *(const pg8::bf16x8*)(BT + (size_t)(32 * wave + 16 * cc + fr) * 256 + ks * 32 + fq * 8);
#pragma unroll
            for (int rt = 0; rt < 2; ++rt)
#pragma unroll
                for (int cc = 0; cc < 2; ++cc) acc[rt][cc] = mfma16(a[rt], b[cc], acc[rt][cc]); }
#pragma unroll
        for (int rt = 0; rt < 2; ++rt)
#pragma unroll
            for (int cc = 0; cc < 2; ++cc)
#pragma unroll
                for (int i = 0; i < 4; ++i) Y[(size_t)(m0 + 16 * rt + 4 * fq + i) * D + 512 + 32 * wave + 16 * cc + fr] = f2bf(acc[rt][cc][i]);
    }
}

DEV void pool_item(const Params& P, int l, int it, unsigned char* lds) {
    const int tid = TID(), lane = tid & 63, wave = tid >> 6, fr = lane & 15, fq = lane >> 4;
    const bf16_t* Z = (const bf16_t*)(P.ws + WS_Z);
    bf16_t* Y = (bf16_t*)(P.ws + WS_H);
    float* ext = (float*)lds;
    bf16_t* As = (bf16_t*)(ext + 96 * 64);
    const int tile = it >> 2, gi = it & 3, hw = 1 << gi;
    const int m0 = tile * 64; const SeqInfo s0 = seq_of(m0);
    const int zc = ZB + gi * 64, x = tid >> 3, c8 = (tid & 7) * 8;
    LDS_SYNC();
    int nrows = 1;
    if (s0.lat) {
        const int rr = s0.t / 64, r_lo = rr - hw > 0 ? rr - hw : 0, r_hi = rr + hw < GRID_ROWS ? rr + hw : GRID_ROWS; nrows = r_hi - r_lo;
        float a[8];
#pragma unroll
        for (int j = 0; j < 8; ++j) a[j] = 0.f;
#pragma unroll
        for (int rq = 0; rq < 16; ++rq) { const int r2 = rr - hw + rq, r2c = r2 < 0 ? 0 : (r2 >= GRID_ROWS ? GRID_ROWS - 1 : r2); const bool ok = rq < 2 * hw && r2 == r2c;
            const pg8::u32x4 v = *(const pg8::u32x4*)(Z + (size_t)(s0.base + r2c * 64 + x) * ZW + zc + c8);
#pragma unroll
            for (int j = 0; j < 4; ++j) { a[2 * j] += ok ? __builtin_bit_cast(float, v[j] << 16) : 0.f; a[2 * j + 1] += ok ? __builtin_bit_cast(float, v[j] & 0xffff0000u) : 0.f; } }
        *(pg8::f32x4*)(ext + (16 + x) * 64 + c8) = (pg8::f32x4){a[0], a[1], a[2], a[3]}; *(pg8::f32x4*)(ext + (16 + x) * 64 + c8 + 4) = (pg8::f32x4){a[4], a[5], a[6], a[7]};
    } else {
#pragma unroll
        for (int r = 0; r < 2; ++r) { const int e = tid + 512 * r; if (e >= 96 * 8) continue; const int xr = (e >> 3) - 16, cc = (e & 7) * 8, t = s0.t + xr, tc = t < 0 ? 0 : (t >= s0.T ? s0.T - 1 : t); float a[8];
            const pg8::u32x4 v = *(const pg8::u32x4*)(Z + (size_t)(s0.base + tc) * ZW + zc + cc);
#pragma unroll
            for (int j = 0; j < 4; ++j) { a[2 * j] = t == tc ? __builtin_bit_cast(float, v[j] << 16) : 0.f; a[2 * j + 1] = t == tc ? __builtin_bit_cast(float, v[j] & 0xffff0000u) : 0.f; }
            *(pg8::f32x4*)(ext + (e >> 3) * 64 + cc) = (pg8::f32x4){a[0], a[1], a[2], a[3]}; *(pg8::f32x4*)(ext + (e >> 3) * 64 + cc + 4) = (pg8::f32x4){a[4], a[5], a[6], a[7]}; }
    }
    LDS_SYNC();
    {
        int lo, hi;
        if (s0.lat) { lo = x - hw > 0 ? x - hw : 0; hi = x + hw < 64 ? x + hw : 64; }
        else { const int t = s0.t + x; lo = (t - hw > 0 ? t - hw : 0) - s0.t; hi = (t + hw < s0.T ? t + hw : s0.T) - s0.t; }
        pg8::f32x4 a0 = {0.f, 0.f, 0.f, 0.f}, a1 = {0.f, 0.f, 0.f, 0.f};
        for (int x2 = lo; x2 < hi; ++x2) { a0 = a0 + *(const pg8::f32x4*)(ext + (16 + x2) * 64 + c8); a1 = a1 + *(const pg8::f32x4*)(ext + (16 + x2) * 64 + c8 + 4); }
        const float sc = 1.f / (float)((hi - lo) * nrows);
        const pg8::u32x4 ov = *(const pg8::u32x4*)(Z + (size_t)(m0 + x) * ZW + zc + c8);
        pg8::u32x4 w;
#pragma unroll
        for (int j = 0; j < 4; ++j) { const float p0 = (j < 2 ? a0[2 * j] : a1[2 * j - 4]) * sc - __builtin_bit_cast(float, ov[j] << 16), p1 = (j < 2 ? a0[2 * j + 1] : a1[2 * j - 3]) * sc - __builtin_bit_cast(float, ov[j] & 0xffff0000u); w[j] = pk2(p0, p1); }
        *(pg8::u32x4*)(As + x * LT + c8) = w;
    }
    LDS_SYNC();
    {
        const bf16_t* BT = (const bf16_t*)(P.ws + WS_SW) + (size_t)l * SW_LAYER + SW_POOL + gi * 4096;
        const int rt = wave >> 1;
#pragma unroll
        for (int cc = 0; cc < 2; ++cc) { const int ct = 2 * (wave & 1) + cc; pg8::f32x4 acc = {0.f, 0.f, 0.f, 0.f};
#pragma unroll
            for (int ks = 0; ks < 2; ++ks) acc = mfma16(*(const pg8::bf16x8*)(As + (16 * rt + fr) * LT + ks * 32 + fq * 8), *(const pg8::bf16x8*)(BT + (16 * ct + fr) * 64 + ks * 32 + fq * 8), acc);
            const float sc = INP(I_POOLS)[(size_t)l * DG + gi * 64 + 16 * ct + fr];
#pragma unroll
            for (int i = 0; i < 4; ++i) Y[(size_t)(m0 + 16 * rt + 4 * fq + i) * D + 256 + gi * 64 + 16 * ct + fr] = f2bf(acc[i] * sc); }
    }
}

constexpr int N_RW_LAT = DEC_BATCH * 8, N_ML_LAT = DEC_BATCH * 8, N_HEAVY = N_RW_LAT + N_ML_LAT;
constexpr int N_RW_CTX = BATCH * 8, N_ML_CTX = BATCH * 8, N_CONV = M / 32, N_POOL = (M / 64) * 4;
DEV void phase_mixers(const Params& P, int l, unsigned char* lds) {
    const int G = gridDim.x, b = blockIdx.x;
    int r0, r1, rs, q0, q1, qs, c0, cs, p0;
    if (G >= 2 * N_HEAVY) {
        const int nb = G - N_HEAVY, bb = b - N_HEAVY;
        if (b < N_RW_LAT) { r0 = b; r1 = b + 1; rs = 1; q0 = 0; q1 = 0; qs = 1; c0 = N_CONV; cs = 1; p0 = N_POOL; }
        else if (b < N_HEAVY) { r0 = 0; r1 = 0; rs = 1; q0 = b - N_RW_LAT; q1 = q0 + 1; qs = 1; c0 = N_CONV; cs = 1; p0 = N_POOL; }
        else { r0 = N_RW_LAT + bb; r1 = N_RW_LAT + N_RW_CTX; rs = nb; q0 = N_ML_LAT + (bb + nb / 2) % nb; q1 = N_ML_LAT + N_ML_CTX; qs = nb; c0 = (bb + nb / 4) % nb; cs = nb; p0 = (bb + 3 * nb / 4) % nb; }
    } else { r0 = b; r1 = N_RW_LAT + N_RW_CTX; rs = G; q0 = b; q1 = N_ML_LAT + N_ML_CTX; qs = G; c0 = b; cs = G; p0 = b; }
    for (int r = r0; r < r1; r += rs) {
        rwkv_chunk_scan_item(P, l, r < N_RW_LAT ? BATCH * 8 + r : r - N_RW_LAT, lds); }
    for (int q = q0; q < q1; q += qs) { const int ch = q < N_ML_LAT ? BATCH * 8 + q : q - N_ML_LAT; mlstm_state_item(P, l, ch, lds); }
    for (int it = c0; it < N_CONV; it += cs) conv_item(P, l, it, lds);
    for (int it = p0; it < N_POOL; it += cs) pool_item(P, l, it, lds);
}

DEV void phase_finalize(const Params& P, int l) {
    const int tid = TID(), lane = tid & 63, wave = tid >> 6;
    const int gw = blockIdx.x * 8 + wave, NGW = gridDim.x * 8;
    bf16_t* Y = (bf16_t*)(P.ws + WS_H);
    const f16* RY = (const f16*)(P.ws + WS_RY); const f16* RG = (const f16*)(P.ws + WS_RG);
    const int c0 = 4 * lane;
    float lg[4], lb[4];
#pragma unroll
    for (int j = 0; j < 4; ++j) { lg[j] = INP(I_LNG)[(size_t)l * DG + c0 + j]; lb[j] = INP(I_LNB)[(size_t)l * DG + c0 + j]; }
    for (int m = gw; m < M; m += NGW) {
        {
            const h4 a = *(const h4*)(RY + (size_t)m * DG + c0), b = *(const h4*)(RY + ((size_t)M + m) * DG + c0), g = *(const h4*)(RG + (size_t)m * DG + c0);
            float y[4]; float s = 0.f;
#pragma unroll
            for (int j = 0; j < 4; ++j) { y[j] = (float)a[j] + (float)b[j]; s += y[j]; }
            const float mean = sum16(s) * (1.f / 64.f); float q2 = 0.f;
#pragma unroll
            for (int j = 0; j < 4; ++j) { y[j] -= mean; q2 += y[j] * y[j]; }
            const float rs = frsq(sum16(q2) * (1.f / 64.f) + 64e-5f);
            float o[4];
#pragma unroll
            for (int j = 0; j < 4; ++j) o[j] = (y[j] * rs * lg[j] + lb[j]) * (float)g[j];
            *(unsigned long long*)(Y + (size_t)m * D + c0) = (unsigned long long)pk2(o[0], o[1]) | ((unsigned long long)pk2(o[2], o[3]) << 32);
        }
    }
}

constexpr int PH_PER_LAYER = 9, NPHASES = 2 + PH_PER_LAYER * DEPTH;
DEV void run_phase(const Params& P, int ph, unsigned char* lds) {
#ifndef PH_MASK
#define PH_MASK 0xFFFF
#endif
    if (ph == 0) { if (PH_MASK & 0x200) phase_prologue(P, lds); return; }
    if (ph == NPHASES - 1) { if (PH_MASK & 0x400) phase_final(P); return; }
    const int l = (ph - 1) / PH_PER_LAYER, k = (ph - 1) % PH_PER_LAYER;
    const int G = gridDim.x, b = blockIdx.x;
    bool is_gemm = false; pg8::Gemm g{nullptr, nullptr, M, 0, 0}; pg8::EpiAny E{};
    switch (k) {
    case 0: if (!(PH_MASK & (1 << 0))) break; phase_norm(P, l, 0); break;
    case 1: g = pg8::Gemm{(const bf16_t*)(P.ws + WS_H), (const bf16_t*)(P.ws + WS_WIN) + (size_t)l * ZW * D, M, ZW, D};
            E.mode = 0; E.perm = true; E.b0 = pg8::EpiBf16<0>{(bf16_t*)(P.ws + WS_Z), ZW, nullptr}; is_gemm = true; break;
    case 2: phase_rwkv_prep(P, l, lds); for (int it = (b + G / 2) % G; it < NTC * 4; it += G) mlstm_local_item(P, l, it, lds); break;
    case 3: phase_mixers(P, l, lds); break;
    case 4: for (int it = b; it < NTC * 4; it += G) mlstm_out_item(P, l, it, lds); phase_finalize(P, l); break;
    case 5: g = pg8::Gemm{(const bf16_t*)(P.ws + WS_H), (const bf16_t*)(P.ws + WS_WOUT) + (size_t)l * D * D, M, D, D};
            E.mode = 2; E.perm = false; E.rs = pg8::EpiRes{l == 0 ? INP(I_XP) : P.out, l == 0 ? INP(I_XS) : P.out + (size_t)M_CTX * D, P.out, mod_vec(P, l, 0) + 2048, nullptr}; is_gemm = true; break;
    case 6: phase_norm(P, l, 1); break;
    case 7: g = pg8::Gemm{(const bf16_t*)(P.ws + WS_H), (const bf16_t*)(P.ws + WS_W1) + (size_t)l * DFF * D, M, DFF, D};
            E.mode = 1; E.perm = true; E.b1 = pg8::EpiBf16<1>{(bf16_t*)(P.ws + WS_OV), DFF, INP(I_B1) + (size_t)l * DFF}; is_gemm = true; break;
    case 8: g = pg8::Gemm{(const bf16_t*)(P.ws + WS_OV), (const bf16_t*)(P.ws + WS_W2) + (size_t)l * D * DFF, M, D, DFF};
            E.mode = 2; E.perm = false; E.rs = pg8::EpiRes{P.out, P.out + (size_t)M_CTX * D, P.out, mod_vec(P, l, 0) + 5120, INP(I_B2) + (size_t)l * D}; is_gemm = true; break;
    }
    if (is_gemm) { pg8::StaticOrder S; S.init(M, g.N, G, b); pg8::gemm_phase<pg8::EpiAny, pg8::StaticOrder, true, true>(LDSP(lds), g, S, E); }
}

#ifndef CPU_EMU
namespace cg = cooperative_groups;
#define LAS __attribute__((address_space(3)))
#define XB_TMO      128
#define XB_XCNT(j)  (256  + 64 * (j))
#define XB_XSUB(j)  (1280 + 64 * (j))
#define XB_XGEN(j)  (2304 + 64 * (j))
#define XB_TOP      3328
#define XB_TOPGEN   3392
#define XCD_BAR_WORDS 3456
#define XB_SPIN_CAP (1u << 22)
__device__ __forceinline__ unsigned xb_ld(unsigned* p)              { return __hip_atomic_load(p, __ATOMIC_RELAXED, __HIP_MEMORY_SCOPE_AGENT); }
__device__ __forceinline__ unsigned xb_add(unsigned* p, unsigned v) { return __hip_atomic_fetch_add(p, v, __ATOMIC_RELAXED, __HIP_MEMORY_SCOPE_AGENT); }
__device__ __forceinline__ unsigned xb_xcc_id() { return (unsigned)__builtin_amdgcn_s_getreg((3 << 11) | 20) & 0xFu; }
#define XB_SPIN(cond, bar) do { unsigned _sp = 0; while (cond) { __builtin_amdgcn_s_sleep(1); \
    if ((++_sp & 255u) == 0u) { if (xb_ld(&(bar)[XB_TMO])) break; if (_sp > XB_SPIN_CAP) { atomicAdd(&(bar)[XB_TMO], 1u); break; } } } } while (0)
struct XcdBarrier { unsigned* bar; unsigned x; volatile LAS unsigned* st; };
__device__ __forceinline__ XcdBarrier xcd_barrier_post(unsigned* bar, volatile LAS unsigned* st) {
    XcdBarrier b; b.bar = bar; b.x = xb_xcc_id(); b.st = st;
    if (threadIdx.x == 0) (void)xb_add(&bar[XB_XCNT(b.x)], 1u);
    return b;
}
__device__ __forceinline__ void xcd_barrier_complete(unsigned* bar, unsigned x, unsigned& nloc, unsigned& nx) {
    const unsigned G = gridDim.x * gridDim.y * gridDim.z;
    unsigned sum, cnt, mine, sp = 0u;
    for (;;) {
        sum = 0u; cnt = 0u; mine = 0u;
#pragma unroll
        for (unsigned j = 0; j < 16; ++j) { const unsigned c = xb_ld(&bar[XB_XCNT(j)]); sum += c; cnt += (c > 0u) ? 1u : 0u; mine = (j == x) ? c : mine; }
        if (sum == G) break;
        __builtin_amdgcn_s_sleep(1);
        if ((++sp & 255u) == 0u) { if (xb_ld(&bar[XB_TMO])) break; if (sp > XB_SPIN_CAP) { atomicAdd(&bar[XB_TMO], 1u); break; } }
    }
    nloc = mine > 0u ? mine : 1u; nx = cnt > 0u ? cnt : 1u;
}
__device__ __forceinline__ void xcd_barrier(const XcdBarrier& b) {
    asm volatile("s_waitcnt vmcnt(0)" ::: "memory");
    __syncthreads();
    if (threadIdx.x == 0) {
        unsigned* bar = b.bar;
        __builtin_amdgcn_s_waitcnt(0);
        unsigned nloc = b.st[0], nx = b.st[1];
        if (nloc == 0u) { xcd_barrier_complete(bar, b.x, nloc, nx); b.st[0] = nloc; b.st[1] = nx; }
        const unsigned old = xb_add(&bar[XB_XSUB(b.x)], 1u);
        const unsigned gen = old / nloc;
        if (old + 1u == (gen + 1u) * nloc) {
            __builtin_amdgcn_fence(__ATOMIC_RELEASE, "agent");
            asm volatile("s_waitcnt vmcnt(0)" ::: "memory");
            const unsigned og = xb_add(&bar[XB_TOP], 1u);
            const unsigned tg = og / nx;
            if (og + 1u == (tg + 1u) * nx) xb_add(&bar[XB_TOPGEN], 1u);
            else XB_SPIN(xb_ld(&bar[XB_TOPGEN]) == tg, bar);
            __builtin_amdgcn_fence(__ATOMIC_ACQUIRE, "agent");
            xb_add(&bar[XB_XGEN(b.x)], 1u);
            asm volatile("s_waitcnt vmcnt(0)" ::: "memory");
        } else {
            XB_SPIN(xb_ld(&bar[XB_XGEN(b.x)]) == gen, bar);
            __builtin_amdgcn_fence(__ATOMIC_ACQUIRE, "agent");
            asm volatile("s_waitcnt vmcnt(0)" ::: "memory");
        }
    }
    __syncthreads();
}

constexpr int MISC_OFF = 131072 + 320;
constexpr size_t CTL_ZERO = 65536;
__global__ void __launch_bounds__(512, 2) mega_fwd(Params P, int ph_lo, int ph_hi) {
    extern __shared__ __attribute__((aligned(16))) unsigned char lds[];
    cg::grid_group grid = cg::this_grid();
    volatile LAS unsigned* misc = (volatile LAS unsigned*)((LAS unsigned char*)lds + MISC_OFF);
    if (threadIdx.x < 32) misc[threadIdx.x] = 0u;
    __syncthreads();
    XcdBarrier bar = xcd_barrier_post((unsigned*)(P.ws + WS_CTL) + 1024, misc + 8);
    for (int ph = ph_lo; ph < ph_hi; ++ph) {
        run_phase(P, ph, lds);
#ifdef PROBE_DOUBLE
        if (ph > 0 && ph < NPHASES - 1 && ((ph - 1) % PH_PER_LAYER) == PROBE_DOUBLE) { xcd_barrier(bar); run_phase(P, ph, lds); }
#endif
        if (ph + 1 < ph_hi) { if (P.ws == nullptr) grid.sync(); else xcd_barrier(bar); }
    }
}

extern "C" void kernel_launch(void* const* d_in, const int* in_sizes, int n_in, void* d_out, int out_size, void* d_ws, size_t ws_size, hipStream_t stream) {
    static int grid = 0;
    if (grid == 0) {
        if (n_in != N_IN || ws_size < WS_END) { fprintf(stderr, "kernel_launch: unexpected n_in %d or ws_size %zu (need %zu)\n", n_in, ws_size, (size_t)WS_END); grid = -1; return; }
        int dev = 0, cus = 0, per_cu = 0;
        (void)hipGetDevice(&dev); (void)hipDeviceGetAttribute(&cus, hipDeviceAttributeMultiprocessorCount, dev);
        (void)hipFuncSetAttribute((const void*)mega_fwd, hipFuncAttributeMaxDynamicSharedMemorySize, LDS_BYTES);
        (void)hipOccupancyMaxActiveBlocksPerMultiprocessor(&per_cu, (const void*)mega_fwd, 512, LDS_BYTES);
        if (per_cu < 1) { fprintf(stderr, "kernel_launch: occupancy query says %d blocks per CU\n", per_cu); per_cu = 1; }
        grid = cus * 1;
    }
    if (grid < 0) return;
    (void)hipMemsetAsync((char*)d_ws + WS_CTL, 0, CTL_ZERO, stream);
    Params p{};
    for (int i = 0; i < N_IN; ++i) p.in[i] = (const float*)d_in[i];
    p.out = (float*)d_out; p.ws = (unsigned char*)d_ws;
    int lo = 0, hi = NPHASES;
    void* args[] = {&p, &lo, &hi};
    hipError_t e = hipLaunchCooperativeKernel((const void*)mega_fwd, dim3(grid), dim3(512), args, LDS_BYTES, stream);
    if (e != hipSuccess) fprintf(stderr, "cooperative launch failed: %s (grid %d)\n", hipGetErrorString(e), grid);
}
#endif
```

```cpp
#ifndef CPU_EMU
#include <hip/hip_runtime.h>
#include <hip/hip_cooperative_groups.h>
#endif
#include <cstdio>
#include <cstdint>
#include <cmath>

#define DEV __device__ __forceinline__

#ifndef CFG_BATCH
#define CFG_BATCH 32
#define CFG_SEQ 256
#define CFG_DEC_BATCH 2
#define CFG_DEC_SEQ 4096
#define CFG_DEPTH 4
#endif
constexpr int D = 1024, BATCH = CFG_BATCH, SEQ = CFG_SEQ, DEC_BATCH = CFG_DEC_BATCH, DEC_SEQ = CFG_DEC_SEQ, DEPTH = CFG_DEPTH;
constexpr int M_CTX = BATCH * SEQ, M_LAT = DEC_BATCH * DEC_SEQ, M = M_CTX + M_LAT;
constexpr int NMOD = 1 + DEC_BATCH;
constexpr int D_IN = 2832, ZW = 3072, DFF = 4096, DG = 256;
constexpr int GRID_W = 64, GRID_ROWS = DEC_SEQ / GRID_W;
constexpr int ZB = 1024, ZC = 1280, ZD = 1792;
constexpr int ZD_V = ZD + 512, ZD_I = ZD + 768, ZD_F = ZD + 776, ZD_O = ZD + 784;
static_assert(M_CTX % 256 == 0 && M_LAT % 256 == 0 && SEQ % 64 == 0 && DEC_SEQ % 64 == 0, "shape");

enum { I_XP = 0, I_XS, I_C, I_SRWKV, I_SC, I_SN, I_SM, I_CCTX, I_WMOD, I_BMOD, I_N1G, I_N2G, I_WIN, I_WOUT,
       I_MU, I_W0, I_WUP, I_A0, I_AUP, I_GUP, I_KK, I_KA, I_RK, I_LNG, I_LNB, I_POOLW, I_POOLS, I_CDW, I_CB, I_CLNG, I_CLNB, I_CPW,
       I_QKCONV, I_IB, I_FB, I_HNG, I_W1, I_B1, I_W2, I_B2, I_FG, N_IN };

typedef unsigned short bf16_t;
typedef _Float16 f16;
constexpr size_t MiB = 1u << 20;
constexpr size_t WS_CTL = 0, CTL_BYTES = 1 * MiB;
constexpr size_t WS_MOD = 65536;
static_assert(WS_MOD + (size_t)DEPTH * NMOD * 6144 * 4 <= CTL_BYTES, "mod");
constexpr size_t WS_WIN = CTL_BYTES;
constexpr size_t WS_WOUT = WS_WIN + (size_t)DEPTH * ZW * D * 2;
constexpr size_t WS_W1 = WS_WOUT + (size_t)DEPTH * D * D * 2;
constexpr size_t WS_W2 = WS_W1 + (size_t)DEPTH * DFF * D * 2;
constexpr size_t WS_H = WS_W2 + (size_t)DEPTH * D * DFF * 2;
constexpr size_t WS_OV = WS_H + (size_t)M * D * 2;
constexpr size_t WS_Z = WS_OV;
constexpr int RCH_REC = 10496;
constexpr size_t WS_RCH = WS_Z + (size_t)M * ZW * 2;
constexpr size_t WS_RV = WS_RCH + (size_t)8 * (M / 16) * RCH_REC;
constexpr size_t WS_RG = WS_RV + (size_t)M * DG * 2;
constexpr size_t WS_RY = WS_RG + (size_t)M * DG * 2;
constexpr int NTC = M / 64;
constexpr size_t WS_UP = WS_RY + (size_t)2 * M * DG * 2;
constexpr size_t WS_CP = WS_UP + (size_t)2 * NTC * 4 * 4096 * 2;
constexpr size_t WS_NU = WS_CP + (size_t)2 * NTC * 4 * 4096 * 2;
constexpr size_t WS_NP = WS_NU + (size_t)2 * NTC * 4 * 64 * 4;
constexpr size_t WS_AB = WS_NP + (size_t)2 * NTC * 4 * 64 * 4;
constexpr size_t WS_MP = WS_AB + (size_t)2 * NTC * 4 * 2 * 4;
constexpr size_t WS_SW = WS_MP + (size_t)2 * NTC * 4 * 4;
constexpr int SW_WUP = 0, SW_AUP = 32768, SW_GUP = 65536, SW_CPW = 98304, SW_POOL = 163840, SW_LAYER = 180224;
constexpr size_t WS_END_A = WS_SW + (size_t)DEPTH * SW_LAYER * 2;
constexpr size_t WS_END_B = WS_OV + (size_t)M * DFF * 2;
constexpr size_t WS_END = WS_END_A > WS_END_B ? WS_END_A : WS_END_B;
#if CFG_BATCH == 32 && CFG_DEC_SEQ == 4096
static_assert(WS_END <= (size_t)384 * MiB, "workspace must fit 4x the largest tensor (384 MiB)");
#endif

constexpr int LDS_BYTES = 147456;

struct Params { const float* in[N_IN]; float* out; unsigned char* ws; };
#ifdef CPU_EMU
#define INP(i) (P.in[i])
#else
__device__ __forceinline__ const float* inp_(const Params& P, int i) { asm volatile("" : "+s"(i)); return P.in[i]; }
#define INP(i) inp_(P, (i))
#endif
#ifdef CPU_EMU
#define TID() ((int)threadIdx.x)
#else
__device__ __forceinline__ int tid_() { int t = threadIdx.x; asm volatile("" : "+v"(t)); return t; }
#define TID() tid_()
#endif

DEV float bf2f(bf16_t h) { unsigned u = (unsigned)h << 16; return __builtin_bit_cast(float, u); }
DEV bf16_t f2bf(float f) { unsigned u = __builtin_bit_cast(unsigned, f); return (bf16_t)((u + 0x7fffu + ((u >> 16) & 1u)) >> 16); }
DEV unsigned pk2(float lo, float hi) { return (unsigned)f2bf(lo) | ((unsigned)f2bf(hi) << 16); }
#ifdef CPU_EMU
DEV float fexp(float x) { return expf(x); }
DEV float flog(float x) { return logf(x); }
DEV float frcp(float x) { return 1.f / x; }
DEV float frsq(float x) { return 1.f / sqrtf(x); }
#else
DEV float fexp(float x) { return __builtin_amdgcn_exp2f(x * 1.44269504088896341f); }
DEV float flog(float x) { return __builtin_amdgcn_logf(x) * 0.69314718055994531f; }
DEV float frcp(float x) { return __builtin_amdgcn_rcpf(x); }
DEV float frsq(float x) { return __builtin_amdgcn_rsqf(x); }
#endif
DEV float sigm(float x) { return frcp(1.f + fexp(-x)); }
DEV float silu_(float x) { return x * sigm(x); }
DEV float softplus_(float x) { return fmaxf(x, 0.f) + flog(1.f + fexp(-fabsf(x))); }
DEV float tanh_(float x) { return 1.f - 2.f * frcp(1.f + fexp(2.f * x)); }
#ifdef CPU_EMU
DEV float dpp_xor1(float v) { return __shfl_xor(v, 1); }
DEV float dpp_xor2(float v) { return __shfl_xor(v, 2); }
DEV float dpp_hmir(float v) { const int l = threadIdx.x & 63; return __shfl(v, (l & ~7) | (7 - (l & 7))); }
DEV float dpp_mir(float v) { const int l = threadIdx.x & 63; return __shfl(v, (l & ~15) | (15 - (l & 15))); }
DEV float lane_get(float v, int src) { return __shfl(v, src); }
#else
template <int CTRL> DEV float dpp_(float v) { return __builtin_bit_cast(float, __builtin_amdgcn_update_dpp(0, __builtin_bit_cast(int, v), CTRL, 0xF, 0xF, true)); }
DEV float dpp_xor1(float v) { return dpp_<0xB1>(v); }
DEV float dpp_xor2(float v) { return dpp_<0x4E>(v); }
DEV float dpp_hmir(float v) { return dpp_<0x141>(v); }
DEV float dpp_mir(float v) { return dpp_<0x140>(v); }
DEV float lane_get(float v, int src) { return __builtin_bit_cast(float, __builtin_amdgcn_readlane(__builtin_bit_cast(int, v), src)); }
#endif
#ifdef CPU_EMU
DEV float lane_up(float v, int delta) { const int l = threadIdx.x & 63; return __shfl(v, l >= delta ? l - delta : l); }
#else
DEV float lane_up(float v, int delta) { return __shfl_up(v, delta); }
#endif
DEV float wave_incl_sum(float x, int lane) {
#pragma unroll
    for (int o = 1; o < 64; o <<= 1) { const float y = lane_up(x, o); if (lane >= o) x += y; }
    return x;
}
DEV float wave_incl_max(float x, int lane) {
#pragma unroll
    for (int o = 1; o < 64; o <<= 1) { const float y = lane_up(x, o); if (lane >= o) x = fmaxf(x, y); }
    return x;
}
DEV float sum16(float v) {
    v += dpp_xor1(v); v += dpp_xor2(v); v += dpp_hmir(v); v += dpp_mir(v); return v;
}
DEV float wave_sum(float v) {
    v = sum16(v);
    return (lane_get(v, 0) + lane_get(v, 16)) + (lane_get(v, 32) + lane_get(v, 48));
}
struct SeqInfo { int base, T, t, lat, sidx; };
DEV SeqInfo seq_of(int m) {
    SeqInfo s;
    if (m < M_CTX) { s.lat = 0; s.sidx = m / SEQ; s.T = SEQ; s.base = s.sidx * SEQ; s.t = m - s.base; }
    else { const int mm = m - M_CTX; s.lat = 1; s.sidx = mm / DEC_SEQ; s.T = DEC_SEQ; s.base = M_CTX + s.sidx * DEC_SEQ; s.t = mm - s.sidx * DEC_SEQ; }
    return s;
}
DEV int mod_index(int m) { return m < M_CTX ? 0 : 1 + (m - M_CTX) / DEC_SEQ; }
DEV const float* mod_vec(const Params& P, int l, int j) { return (const float*)(P.ws + WS_MOD) + ((size_t)l * NMOD + j) * 6144; }
DEV const float* xrow(const Params& P, bool from_input, int m) {
    if (from_input) return m < M_CTX ? INP(I_XP) + (size_t)m * D : INP(I_XS) + (size_t)(m - M_CTX) * D;
    return P.out + (size_t)m * D;
}

namespace pg8 {
typedef short bf16x8 __attribute__((ext_vector_type(8)));
typedef float f32x4 __attribute__((ext_vector_type(4)));
typedef unsigned u32x4 __attribute__((ext_vector_type(4)));
constexpr int BM = 256, BK = 64, HALF = 128, HTB = HALF * BK * 2, STAGE_BYTES = 8 * HTB, NXCD = 8, WGM = 4;
struct Unit { int pm, pn; };
struct Gemm { const bf16_t* A; const bf16_t* Bt; int M, N, K; };
struct StaticOrder {
    int nM, nN, nwg, G, c;
    __host__ __device__ void init(int M_, int N_, int G_, int c_) { nM = M_ / BM; nN = N_ / BM; nwg = nM * nN; G = G_; c = c_; }
    __host__ __device__ bool next(int i, Unit& u) const {
        const long L = (long)i * G + c; if (L >= nwg) return false;
        int wgid = (int)L; { const int q = nwg / NXCD, r = nwg % NXCD, xcd = wgid % NXCD, off = wgid / NXCD; wgid = (xcd < r ? xcd * (q + 1) : r * (q + 1) + (xcd - r) * q) + off; }
        const int nig = WGM * nN, gid = wgid / nig, fm = gid * WGM, gsz = (nM - fm) < WGM ? (nM - fm) : WGM;
        u.pm = fm + ((wgid % nig) % gsz); u.pn = (wgid % nig) / gsz; return true;
    }
    __device__ __forceinline__ void a_ready(const Unit&) const {}
    __device__ __forceinline__ void done(const Unit&) const {}
};

#ifdef CPU_EMU
#define PG8_LAS
DEV unsigned cvt_pk_bf16(float lo, float hi) { return pk2(lo, hi); }
template <class Epi, class Sched, bool ALIGN_EPI = false, bool SP2 = false>
DEV void gemm_phase(unsigned char* lds, const Gemm g, const Sched& S, const Epi& E) {
    const int tid = TID(), wid = tid >> 6, lane = tid & 63, wr = wid >> 2, wc = wid & 3, fr = lane & 15, fq = lane >> 4;
    Unit cur;
    for (int ui = 0; S.next(ui, cur); ++ui) {
        f32x4 acc[2][2][4][2];
        for (int ai = 0; ai < 2; ++ai) for (int bj = 0; bj < 2; ++bj) for (int m = 0; m < 4; ++m) for (int n = 0; n < 2; ++n) for (int j = 0; j < 4; ++j) {
            const int row = cur.pm * BM + ai * HALF + wr * 64 + m * 16 + fr;
            const int col = cur.pn * BM + bj * HALF + wc * 32 + (E.perm ? 8 * fq + 4 * n + j : 16 * n + 4 * fq + j);
            const bf16_t* a = g.A + (size_t)row * g.K; const bf16_t* b = g.Bt + (size_t)col * g.K;
            float s = 0.f; for (int k = 0; k < g.K; ++k) s += bf2f(a[k]) * bf2f(b[k]);
            acc[ai][bj][m][n][j] = s;
        }
        E(acc, cur, wr, wc, fr, fq);
    }
}
#else
#define PG8_LAS __attribute__((address_space(3)))
__host__ __device__ __forceinline__ int lds_byte(int r, int c) { const int st = (r >> 4) * 2 + (c >> 5), rr = r & 15, cc = c & 31, ob = rr * 64 + cc * 2; return st * 1024 + (ob ^ (((ob >> 9) & 1) << 5)); }
__host__ __device__ __forceinline__ void stage_rc(int b, int& R, int& C) { const int st = b / 1024, sb = b % 1024, swz = sb ^ (((sb >> 9) & 1) << 5); R = (st >> 1) * 16 + swz / 64; C = (st & 1) * 32 + (swz % 64) / 2; }
__host__ __device__ __forceinline__ int perm32(int rho) { const int n = rho >> 4, i = rho & 15; return 8 * (i >> 2) + 4 * n + (i & 3); }
__device__ __forceinline__ unsigned cvt_pk_bf16(float lo, float hi) { unsigned r; asm volatile("v_cvt_pk_bf16_f32 %0, %1, %2" : "=v"(r) : "v"(lo), "v"(hi)); return r; }

template <class Epi, class Sched, bool ALIGN_EPI = false, bool SP2 = false>
__device__ __forceinline__ void gemm_phase(PG8_LAS unsigned char* lds, const Gemm g, const Sched& S, const Epi& E) {
    const int tid = TID(), wid = __builtin_amdgcn_readfirstlane(tid >> 6), lane = tid & 63, wr = wid >> 2, wc = wid & 3, fr = lane & 15, fq = lane >> 4;
    const int K = g.K, nt = K / BK;
    unsigned voffA[2], voffB[2];
#pragma unroll
    for (int i = 0; i < 2; ++i) { int R, C; stage_rc(tid * 16 + i * 8192, R, C); const int Rb = E.perm ? ((R & ~31) + perm32(R & 31)) : R;
        voffA[i] = (unsigned)(R * K + C) * 2u; voffB[i] = (unsigned)(Rb * K + C) * 2u; }
    const size_t kstep = (size_t)(BK * 2);
    const size_t hstep = (size_t)HALF * K * 2;
    const size_t tstep = 2 * hstep;
    const unsigned ldsw = (unsigned)wid * 1024u;
    const int aoff = lds_byte(wr * 64 + fr, fq * 8), boff = lds_byte(wc * 32 + fr, fq * 8);
#define PG8_SA(b, h) (((b) * 2 + (h)) * HTB)
#define PG8_SB(b, h) ((4 + (b) * 2 + (h)) * HTB)
#define PG8_STAGE(bufoff, gbase, voff) do { _Pragma("unroll") for (int _i = 0; _i < 2; ++_i) \
        __builtin_amdgcn_global_load_lds((const unsigned*)((const char*)(gbase) + (voff)[_i]), (PG8_LAS unsigned*)(lds + (bufoff) + ldsw + _i * 8192), 16, 0, 0); } while (0)
#define PG8_LDA(dst, b, h) do { _Pragma("unroll") for (int m = 0; m < 4; ++m) _Pragma("unroll") for (int k = 0; k < 2; ++k) dst[m][k] = *(const PG8_LAS bf16x8*)(lds + PG8_SA(b, h) + aoff + m * 2048 + k * 1024); } while (0)
#define PG8_LDB(dst, b, h) do { _Pragma("unroll") for (int n = 0; n < 2; ++n) _Pragma("unroll") for (int k = 0; k < 2; ++k) dst[n][k] = *(const PG8_LAS bf16x8*)(lds + PG8_SB(b, h) + boff + n * 2048 + k * 1024); } while (0)
#define PG8_MMA(ai, bj, At, Bt) do { __builtin_amdgcn_s_setprio(1); _Pragma("unroll") for (int m = 0; m < 4; ++m) _Pragma("unroll") for (int n = 0; n < 2; ++n) _Pragma("unroll") for (int k = 0; k < 2; ++k) \
        acc[ai][bj][m][n] = __builtin_amdgcn_mfma_f32_16x16x32_bf16(Bt[n][k], At[m][k], acc[ai][bj][m][n], 0, 0, 0); __builtin_amdgcn_s_setprio(0); } while (0)
#define PG8_WAIT_V(n) asm volatile("s_waitcnt vmcnt(" #n ")" ::: "memory")
#define PG8_WAIT_L(n) asm volatile("s_waitcnt lgkmcnt(" #n ")" ::: "memory")
#define PG8_BAR __builtin_amdgcn_s_barrier()
#define PG8_SCHED __builtin_amdgcn_sched_barrier(0)
    Unit cur, nxt; int ui = 0;
    if (!S.next(0, cur)) return;
    f32x4 acc[2][2][4][2];
#pragma unroll
    for (int a = 0; a < 2; ++a)
#pragma unroll
        for (int b = 0; b < 2; ++b)
#pragma unroll
            for (int m = 0; m < 4; ++m)
#pragma unroll
                for (int n = 0; n < 2; ++n) acc[a][b][m][n] = (f32x4){0.f, 0.f, 0.f, 0.f};
    bf16x8 At[4][2], B0[2][2], B1[2][2];
    const char* cA = (const char*)g.A + (size_t)cur.pm * tstep; const char* cB = (const char*)g.Bt + (size_t)cur.pn * tstep;
    S.a_ready(cur);
    if constexpr (SP2) {
        PG8_STAGE(PG8_SB(0, 0), cB, voffB); PG8_STAGE(PG8_SB(0, 1), cB + hstep, voffB); PG8_STAGE(PG8_SA(0, 0), cA, voffA); PG8_STAGE(PG8_SA(0, 1), cA + hstep, voffA);
        if (wr == 1) PG8_BAR;
        PG8_WAIT_V(2); PG8_BAR;
        PG8_STAGE(PG8_SB(1, 0), cB + kstep, voffB); PG8_STAGE(PG8_SA(1, 0), cA + kstep, voffA); PG8_STAGE(PG8_SB(1, 1), cB + hstep + kstep, voffB);
        PG8_WAIT_V(6); PG8_BAR;
    } else {
        PG8_STAGE(PG8_SB(0, 0), cB, voffB); PG8_STAGE(PG8_SA(0, 0), cA, voffA); PG8_STAGE(PG8_SB(0, 1), cB + hstep, voffB); PG8_STAGE(PG8_SA(0, 1), cA + hstep, voffA);
        if (wr == 1) PG8_BAR;
        PG8_WAIT_V(4); PG8_BAR;
        PG8_STAGE(PG8_SB(1, 0), cB + kstep, voffB); PG8_STAGE(PG8_SA(1, 0), cA + kstep, voffA); PG8_STAGE(PG8_SB(1, 1), cB + hstep + kstep, voffB);
        PG8_WAIT_V(6); PG8_BAR;
    }
    for (;;) {
        const bool has_next = S.next(ui + 1, nxt);
        const char* nA = has_next ? (const char*)g.A + (size_t)nxt.pm * tstep : cA; const char* nB = has_next ? (const char*)g.Bt + (size_t)nxt.pn * tstep : cB;
        for (int t = 0; t < nt; t += 2) {
            const bool last = (t == nt - 2);
            const char* a1 = cA + (size_t)(t + 1) * kstep;
            const char* a2 = last ? nA : cA + (size_t)(t + 2) * kstep; const char* b2 = last ? nB : cB + (size_t)(t + 2) * kstep;
            const char* a3 = a2 + kstep; const char* b3 = b2 + kstep;
            if (last && has_next) S.a_ready(nxt);
            if constexpr (SP2) {
            PG8_LDB(B0, 0, 0); PG8_LDB(B1, 0, 1); PG8_SCHED; PG8_LDA(At, 0, 0); PG8_STAGE(PG8_SA(1, 1), a1 + hstep, voffA);
            PG8_WAIT_V(8); PG8_WAIT_L(0); PG8_BAR; PG8_MMA(0, 0, At, B0); PG8_MMA(0, 1, At, B1); PG8_BAR; PG8_SCHED;
            PG8_LDA(At, 0, 1); PG8_STAGE(PG8_SB(0, 0), b2, voffB); PG8_STAGE(PG8_SB(0, 1), b2 + hstep, voffB); PG8_STAGE(PG8_SA(0, 0), a2, voffA);
            PG8_WAIT_V(8); PG8_WAIT_L(0); PG8_BAR; PG8_MMA(1, 0, At, B0); PG8_MMA(1, 1, At, B1); PG8_BAR; PG8_SCHED;
            PG8_LDB(B0, 1, 0); PG8_LDB(B1, 1, 1); PG8_SCHED; PG8_LDA(At, 1, 0); PG8_STAGE(PG8_SA(0, 1), a2 + hstep, voffA);
            PG8_WAIT_V(8); PG8_WAIT_L(0); PG8_BAR; PG8_MMA(0, 0, At, B0); PG8_MMA(0, 1, At, B1); PG8_BAR; PG8_SCHED;
            PG8_LDA(At, 1, 1); PG8_STAGE(PG8_SB(1, 0), b3, voffB); PG8_STAGE(PG8_SB(1, 1), b3 + hstep, voffB); PG8_STAGE(PG8_SA(1, 0), a3, voffA);
            PG8_WAIT_V(8); PG8_WAIT_L(0); PG8_BAR; PG8_MMA(1, 0, At, B0); PG8_MMA(1, 1, At, B1); PG8_BAR; PG8_SCHED;
            } else {
            PG8_LDB(B0, 0, 0); PG8_SCHED; PG8_LDA(At, 0, 0); PG8_STAGE(PG8_SA(1, 1), a1 + hstep, voffA);
            PG8_WAIT_L(8); PG8_BAR; PG8_WAIT_L(0); PG8_MMA(0, 0, At, B0); PG8_BAR; PG8_SCHED;
            PG8_LDB(B1, 0, 1); PG8_STAGE(PG8_SB(0, 0), b2, voffB);
            PG8_BAR; PG8_WAIT_L(0); PG8_MMA(0, 1, At, B1); PG8_BAR;
            PG8_LDA(At, 0, 1); PG8_STAGE(PG8_SA(0, 0), a2, voffA);
            PG8_BAR; PG8_WAIT_L(0); PG8_MMA(1, 0, At, B0); PG8_BAR; PG8_SCHED;
            PG8_STAGE(PG8_SB(0, 1), b2 + hstep, voffB);
            PG8_WAIT_V(6); PG8_BAR; PG8_MMA(1, 1, At, B1); PG8_BAR;
            PG8_LDB(B0, 1, 0); PG8_SCHED; PG8_LDA(At, 1, 0); PG8_STAGE(PG8_SA(0, 1), a2 + hstep, voffA);
            PG8_WAIT_L(8); PG8_BAR; PG8_WAIT_L(0); PG8_MMA(0, 0, At, B0); PG8_BAR; PG8_SCHED;
            PG8_LDB(B1, 1, 1); PG8_STAGE(PG8_SB(1, 0), b3, voffB);
            PG8_BAR; PG8_WAIT_L(0); PG8_MMA(0, 1, At, B1); PG8_BAR;
            PG8_LDA(At, 1, 1); PG8_STAGE(PG8_SA(1, 0), a3, voffA);
            PG8_BAR; PG8_WAIT_L(0); PG8_MMA(1, 0, At, B0); PG8_BAR; PG8_SCHED;
            PG8_STAGE(PG8_SB(1, 1), b3 + hstep, voffB);
            PG8_WAIT_V(6); PG8_BAR; PG8_MMA(1, 1, At, B1); PG8_BAR;
            }
        }
        if constexpr (ALIGN_EPI) { if (wr == 0) PG8_BAR; }
        E(acc, cur, wr, wc, fr, fq); S.done(cur);
        if (!has_next) break;
#pragma unroll
        for (int a = 0; a < 2; ++a)
#pragma unroll
            for (int b = 0; b < 2; ++b)
#pragma unroll
                for (int m = 0; m < 4; ++m)
#pragma unroll
                    for (int n = 0; n < 2; ++n) acc[a][b][m][n] = (f32x4){0.f, 0.f, 0.f, 0.f};
        cur = nxt; cA = nA; cB = nB; ++ui;
        if constexpr (ALIGN_EPI) { if (wr == 1) PG8_BAR; }
    }
    PG8_WAIT_V(0);
    if constexpr (!ALIGN_EPI) { if (wr == 0) PG8_BAR; }
    PG8_BAR;
#undef PG8_SA
#undef PG8_SB
#undef PG8_STAGE
#undef PG8_LDA
#undef PG8_LDB
#undef PG8_MMA
#undef PG8_WAIT_V
#undef PG8_WAIT_L
#undef PG8_BAR
#undef PG8_SCHED
}
#endif

template <int ACT  > struct EpiBf16 {
    static constexpr bool PERM = true, AFTER_DRAIN = false;
    bf16_t* O; int ldc; const float* bias;
    DEV void operator()(const f32x4 (&acc)[2][2][4][2], const Unit& u, int wr, int wc, int fr, int fq) const {
        const int row0 = u.pm * BM + wr * 64 + fr, col0 = u.pn * BM + wc * 32 + 8 * fq;
        f32x4 bv[2][2];
#pragma unroll
        for (int bj = 0; bj < 2; ++bj)
#pragma unroll
            for (int n = 0; n < 2; ++n) bv[bj][n] = bias ? *(const f32x4*)(bias + col0 + bj * HALF + 4 * n) : (f32x4){0.f, 0.f, 0.f, 0.f};
#pragma unroll
        for (int ai = 0; ai < 2; ++ai)
#pragma unroll
            for (int m = 0; m < 4; ++m) { bf16_t* rowp = O + (size_t)(row0 + ai * HALF + m * 16) * ldc + col0;
#pragma unroll
                for (int bj = 0; bj < 2; ++bj) { f32x4 v0 = acc[ai][bj][m][0] + bv[bj][0], v1 = acc[ai][bj][m][1] + bv[bj][1];
                    if (ACT == 1) {
#pragma unroll
                        for (int j = 0; j < 4; ++j) { const float a = fmaxf(v0[j], 0.f), b = fmaxf(v1[j], 0.f); v0[j] = a * a; v1[j] = b * b; } }
                    u32x4 w; w.x = cvt_pk_bf16(v0[0], v0[1]); w.y = cvt_pk_bf16(v0[2], v0[3]); w.z = cvt_pk_bf16(v1[0], v1[1]); w.w = cvt_pk_bf16(v1[2], v1[3]);
                    *(u32x4*)(rowp + bj * HALF) = w; } }
    }
};
struct EpiRes {
    static constexpr bool PERM = false, AFTER_DRAIN = false;
    const float* base_ctx; const float* base_lat; float* out; const float* gate; const float* bias;
    DEV void operator()(const f32x4 (&acc)[2][2][4][2], const Unit& u, int wr, int wc, int fr, int fq) const {
        const int col0 = u.pn * BM + wc * 32 + 4 * fq;
#pragma unroll
        for (int ai = 0; ai < 2; ++ai)
#pragma unroll
            for (int m = 0; m < 4; ++m) { const int r = u.pm * BM + ai * HALF + wr * 64 + m * 16 + fr;
                const float* bs = r < M_CTX ? base_ctx + (size_t)r * D : base_lat + (size_t)(r - M_CTX) * D;
                const float* gt = gate + (size_t)mod_index(r) * 6144; float* orow = out + (size_t)r * D;
#pragma unroll
                for (int bj = 0; bj < 2; ++bj)
#pragma unroll
                    for (int n = 0; n < 2; ++n) { const int c = col0 + bj * HALF + n * 16;
                        f32x4 v = acc[ai][bj][m][n]; if (bias) v = v + *(const f32x4*)(bias + c);
                        const f32x4 o = *(const f32x4*)(bs + c) + *(const f32x4*)(gt + c) * v; *(f32x4*)(orow + c) = o; } }
    }
};
struct EpiAny {
    static constexpr bool AFTER_DRAIN = false;
    int mode; bool perm; EpiBf16<0> b0; EpiBf16<1> b1; EpiRes rs;
    DEV void operator()(const f32x4 (&acc)[2][2][4][2], const Unit& u, int wr, int wc, int fr, int fq) const {
        if (mode == 0) b0(acc, u, wr, wc, fr, fq); else if (mode == 1) b1(acc, u, wr, wc, fr, fq); else rs(acc, u, wr, wc, fr, fq);
    }
};
}

#ifdef CPU_EMU
#define LDSP(p) (p)
#else
#define LDSP(p) ((PG8_LAS unsigned char*)(p))
#endif

constexpr int LT = 72;
#ifdef CPU_EMU
DEV pg8::f32x4 mfma16(pg8::bf16x8 a, pg8::bf16x8 b, pg8::f32x4 c) { return emu::mfma16(a, b, c); }
#else
DEV pg8::f32x4 mfma16(pg8::bf16x8 a, pg8::bf16x8 b, pg8::f32x4 c) { return __builtin_amdgcn_mfma_f32_16x16x32_bf16(a, b, c, 0, 0, 0); }
#endif
typedef f16 h4 __attribute__((ext_vector_type(4)));
#ifdef CPU_EMU
DEV pg8::f32x4 mfma16h(h4 a, h4 b, pg8::f32x4 c) { return emu::mfma16h(a, b, c); }
#else
DEV pg8::f32x4 mfma16h(h4 a, h4 b, pg8::f32x4 c) { return __builtin_amdgcn_mfma_f32_16x16x16f16(a, b, c, 0, 0, 0); }
#endif
DEV h4 cvt_h4(pg8::f32x4 v) { return (h4){(f16)v[0], (f16)v[1], (f16)v[2], (f16)v[3]}; }
DEV pg8::f32x4 tile_mm64(const bf16_t* A, int r0, const bf16_t* Bt, int c0, int fr, int fq) {
    pg8::f32x4 acc = {0.f, 0.f, 0.f, 0.f};
#pragma unroll
    for (int ks = 0; ks < 2; ++ks) { const pg8::bf16x8 a = *(const pg8::bf16x8*)(A + (r0 + fr) * LT + ks * 32 + fq * 8), b = *(const pg8::bf16x8*)(Bt + (c0 + fr) * LT + ks * 32 + fq * 8); acc = mfma16(a, b, acc); }
    return acc;
}

DEV void transpose_item(const float* W, int K, int N, int Npad, bf16_t* WT, int item, float* s  ) {
    const int tid = TID(), nblk = Npad / 256, kb = item / nblk, nb = item % nblk, k0 = kb * 64, n0 = nb * 256;
    {
        const int n = tid & 255, kp = tid >> 8; const bool ok = n0 + n < N; const float* wp = W + (size_t)(k0 + kp) * N + n0 + (ok ? n : 0);
        float tv[32];
#pragma unroll
        for (int i = 0; i < 32; ++i) tv[i] = wp[(size_t)(2 * i) * N];
#pragma unroll
        for (int i = 0; i < 32; ++i) s[(2 * i + kp) * 257 + n] = ok ? tv[i] : 0.f;
    }
    __syncthreads();
#pragma unroll
    for (int j = 0; j < 4; ++j) {
        const int q = tid + 512 * j, c = q & 7, n = q >> 3;
        const float* sp = s + (8 * c) * 257 + n;
        pg8::u32x4 o; o.x = pk2(sp[0], sp[257]); o.y = pk2(sp[2 * 257], sp[3 * 257]); o.z = pk2(sp[4 * 257], sp[5 * 257]); o.w = pk2(sp[6 * 257], sp[7 * 257]);
        *(pg8::u32x4*)(WT + (size_t)(n0 + n) * K + k0 + 8 * c) = o;
    }
    __syncthreads();
}
DEV void phase_prologue(const Params& P, unsigned char* lds) {
    const int tid = TID();
    float* s = (float*)lds;
    constexpr int I_IN = 16 * (ZW / 256), I_OUT = 16 * 4, I_1 = 16 * 16, I_2 = 64 * 4, I_L = I_IN + I_OUT + I_1 + I_2;
    for (int it = blockIdx.x; it < DEPTH * I_L; it += gridDim.x) {
        const int l = it / I_L; int r = it % I_L;
        if (r < I_IN) { transpose_item(INP(I_WIN) + (size_t)l * D * D_IN, D, D_IN, ZW, (bf16_t*)(P.ws + WS_WIN) + (size_t)l * ZW * D, r, s); continue; } r -= I_IN;
        if (r < I_OUT) { transpose_item(INP(I_WOUT) + (size_t)l * D * D, D, D, D, (bf16_t*)(P.ws + WS_WOUT) + (size_t)l * D * D, r, s); continue; } r -= I_OUT;
        if (r < I_1) { transpose_item(INP(I_W1) + (size_t)l * D * DFF, D, DFF, DFF, (bf16_t*)(P.ws + WS_W1) + (size_t)l * DFF * D, r, s); continue; } r -= I_1;
        transpose_item(INP(I_W2) + (size_t)l * DFF * D, DFF, D, D, (bf16_t*)(P.ws + WS_W2) + (size_t)l * D * DFF, r, s);
    }
    for (int e = blockIdx.x * 512 + tid; e < DEPTH * SW_LAYER; e += gridDim.x * 512) {
        const int l = e / SW_LAYER, q = e % SW_LAYER; float v;
        if (q < SW_AUP) { const int d = q >> 14, c = (q >> 6) & 255, j = q & 63; v = INP(I_WUP)[(((size_t)l * 2 + d) * 64 + j) * DG + c]; }
        else if (q < SW_GUP) { const int q2 = q - SW_AUP, d = q2 >> 14, c = (q2 >> 6) & 255, j = q2 & 63; v = INP(I_AUP)[(((size_t)l * 2 + d) * 64 + j) * DG + c]; }
        else if (q < SW_CPW) { const int q2 = q - SW_GUP, c = q2 >> 7, j = q2 & 127; v = INP(I_GUP)[((size_t)l * 128 + j) * DG + c]; }
        else if (q < SW_POOL) { const int q2 = q - SW_CPW, co = q2 >> 8, ci = q2 & 255; v = INP(I_CPW)[((size_t)l * DG + ci) * DG + co]; }
        else { const int q2 = q - SW_POOL, gi = q2 >> 12, o = (q2 >> 6) & 63, ci = q2 & 63; v = INP(I_POOLW)[(((size_t)l * 4 + gi) * 64 + ci) * 64 + o]; }
        ((bf16_t*)(P.ws + WS_SW))[e] = f2bf(v);
    }
    for (int it = blockIdx.x; it < DEPTH * 96; it += gridDim.x) {
        const int l = it / 96, n0 = (it % 96) * 64, n = tid & 63, kg = tid >> 6;
        __syncthreads();
        for (int e = tid; e < NMOD * 1024; e += 512) { const int j = e >> 10, k = e & 1023; const float cv = (j == 0) ? INP(I_CCTX)[k] : INP(I_C)[(size_t)(j - 1) * D + k]; s[e] = silu_(cv); }
        __syncthreads();
        const float* w = INP(I_WMOD) + ((size_t)l * D + kg * 128) * 6144 + n0 + n;
        float a[NMOD];
#pragma unroll
        for (int j = 0; j < NMOD; ++j) a[j] = 0.f;
#pragma unroll
        for (int kb = 0; kb < 4; ++kb) { float wv[32];
#pragma unroll
            for (int k = 0; k < 32; ++k) wv[k] = w[(size_t)(kb * 32 + k) * 6144];
#pragma unroll
            for (int k = 0; k < 32; ++k)
#pragma unroll
                for (int j = 0; j < NMOD; ++j) a[j] += s[j * 1024 + kg * 128 + kb * 32 + k] * wv[k]; }
        float* part = s + NMOD * 1024;
#pragma unroll
        for (int j = 0; j < NMOD; ++j) part[(kg * NMOD + j) * 64 + n] = a[j];
        __syncthreads();
        if (tid < NMOD * 64) { const int j = tid >> 6, nn = tid & 63; float t = INP(I_BMOD)[(size_t)l * 6144 + n0 + nn];
#pragma unroll
            for (int g = 0; g < 8; ++g) t += part[(g * NMOD + j) * 64 + nn];
            ((float*)(P.ws + WS_MOD))[((size_t)l * NMOD + j) * 6144 + n0 + nn] = t; }
    }
}

DEV void phase_norm(const Params& P, int l, int which  ) {
    const int tid = TID(), lane = tid & 63, wave = tid >> 6;
    const int gw = blockIdx.x * 8 + wave, NGW = gridDim.x * 8;
    const float* ng = INP(which ? I_N2G : I_N1G) + (size_t)l * D;
    const bool from_input = (l == 0 && which == 0);
    bf16_t* H = (bf16_t*)(P.ws + WS_H);
    for (int m0 = gw; m0 < M; m0 += 2 * NGW) {
        const int mm[2] = {m0, m0 + NGW < M ? m0 + NGW : m0};
        pg8::f32x4 v[2][4]; float ss[2] = {0.f, 0.f};
#pragma unroll
        for (int q = 0; q < 2; ++q) { const float* xr = xrow(P, from_input, mm[q]);
#pragma unroll
            for (int j = 0; j < 4; ++j) v[q][j] = *(const pg8::f32x4*)(xr + 4 * lane + 256 * j); }
#pragma unroll
        for (int q = 0; q < 2; ++q) {
#pragma unroll
            for (int j = 0; j < 4; ++j) ss[q] += (v[q][j][0] * v[q][j][0] + v[q][j][1] * v[q][j][1]) + (v[q][j][2] * v[q][j][2] + v[q][j][3] * v[q][j][3]);
            const float rs = frsq(wave_sum(ss[q]) * (1.f / D) + 1e-6f);
            const float* mv = mod_vec(P, l, mod_index(mm[q])) + which * 3072;
#pragma unroll
            for (int j = 0; j < 4; ++j) { const int c = 4 * lane + 256 * j;
                const pg8::f32x4 g = *(const pg8::f32x4*)(ng + c), sh = *(const pg8::f32x4*)(mv + c), sc = *(const pg8::f32x4*)(mv + 1024 + c);
                const pg8::f32x4 o = v[q][j] * rs * g * (sc + 1.f) + sh;
                unsigned long long w = (unsigned long long)pk2(o[0], o[1]) | ((unsigned long long)pk2(o[2], o[3]) << 32);
                *(unsigned long long*)(H + (size_t)mm[q] * D + c) = w; } }
    }
}
DEV void phase_final(const Params& P) {
    const int tid = TID(), lane = tid & 63, wave = tid >> 6;
    const int gw = blockIdx.x * 8 + wave, NGW = gridDim.x * 8;
    const float* ng = INP(I_FG);
    for (int m = gw; m < M; m += NGW) {
        float* xr = P.out + (size_t)m * D;
        pg8::f32x4 v[4]; float ss = 0.f;
#pragma unroll
        for (int j = 0; j < 4; ++j) { v[j] = *(const pg8::f32x4*)(xr + 4 * lane + 256 * j); ss += (v[j][0] * v[j][0] + v[j][1] * v[j][1]) + (v[j][2] * v[j][2] + v[j][3] * v[j][3]); }
        const float rs = frsq(wave_sum(ss) * (1.f / D) + 1e-6f);
#pragma unroll
        for (int j = 0; j < 4; ++j) { const int c = 4 * lane + 256 * j; *(pg8::f32x4*)(xr + c) = v[j] * rs * *(const pg8::f32x4*)(ng + c); }
    }
}

constexpr int ZS_LD = 1024 + 8;
DEV float zmix(const bf16_t* Zs, int row, int col, float mu) {
    const float z0 = bf2f(Zs[row * ZS_LD + col]); return z0 + (0.5f * (bf2f(Zs[(row - 1) * ZS_LD + col]) + bf2f(Zs[(row + 1) * ZS_LD + col])) - z0) * mu;
}
DEV void rwkv_prep_item(const Params& P, int l, int it, unsigned char* lds) {
    const int tid = TID(), lane = tid & 63, wave = tid >> 6, fr = lane & 15, fq = lane >> 4;
    const bf16_t* Z = (const bf16_t*)(P.ws + WS_Z);
    bf16_t* Zs = (bf16_t*)lds; bf16_t* LRw = (bf16_t*)(lds + 111616); bf16_t* LRa = LRw + 32 * 72; bf16_t* LRg = LRa + 32 * 72; float* inv = (float*)(LRg + 32 * 136);
    const bf16_t* SW = (const bf16_t*)(P.ws + WS_SW) + (size_t)l * SW_LAYER;
    const int m0 = it * 32; const SeqInfo s0 = seq_of(m0);
    __syncthreads();
#pragma unroll
    for (int r = 0; r < 9; ++r) { const int e = tid + 512 * r, row = e >> 7, ch = e & 127, t = s0.t - 1 + row, tc = t < 0 ? 0 : (t >= s0.T ? s0.T - 1 : t);
        if (e < 34 * 128) { pg8::u32x4 v = *(const pg8::u32x4*)(Z + (size_t)(s0.base + tc) * ZW + ch * 8); if (t != tc) v = (pg8::u32x4){0u, 0u, 0u, 0u};
            *(pg8::u32x4*)(Zs + row * ZS_LD + ch * 8) = v; } }
    __syncthreads();
    {
        const int c = tid & 255, tg = tid >> 8; const float* mu = INP(I_MU) + (size_t)l * 1024; const float mu_k = mu[256 + c], mu_l = mu[768 + c], k_k = INP(I_KK)[(size_t)l * DG + c];
#pragma unroll 4
        for (int tt = 0; tt < 16; ++tt) { const int tl = tg * 16 + tt;
            const float lo = zmix(Zs, tl + 1, 768 + c, mu_l);
            if (c < 64) LRw[tl * 72 + c] = f2bf(tanh_(lo)); else if (c < 128) LRa[tl * 72 + c - 64] = f2bf(lo); else LRg[tl * 136 + c - 128] = f2bf(sigm(lo));
            const float kk = zmix(Zs, tl + 1, 256 + c, mu_k) * k_k, ssq = wave_sum(kk * kk);
            if (lane == 0) inv[tl * 4 + (c >> 6)] = frsq(ssq + 1e-12f); }
    }
    __syncthreads();
    const int h = wave & 3, rt = wave >> 2;
    float rv[4][4], kv[4][4], kkv[4][4];
    {
        pg8::f32x4 ag[4];
#pragma unroll
        for (int ct = 0; ct < 4; ++ct) { ag[ct] = (pg8::f32x4){0.f, 0.f, 0.f, 0.f};
#pragma unroll
            for (int ks = 0; ks < 4; ++ks) ag[ct] = mfma16(*(const pg8::bf16x8*)(LRg + (16 * rt + fr) * 136 + ks * 32 + fq * 8), *(const pg8::bf16x8*)(SW + SW_GUP + (64 * h + 16 * ct + fr) * 128 + ks * 32 + fq * 8), ag[ct]); }
        const float* mu = INP(I_MU) + (size_t)l * 1024;
#pragma unroll
        for (int ct = 0; ct < 4; ++ct) { const int c = 64 * h + 16 * ct + fr; const float mu_r = mu[c], mu_k = mu[256 + c], mu_v = mu[512 + c], k_k = INP(I_KK)[(size_t)l * DG + c];
#pragma unroll
            for (int i = 0; i < 4; ++i) { const int tl = 16 * rt + 4 * fq + i; const size_t o = (size_t)(m0 + tl) * DG + c;
                const float r = zmix(Zs, tl + 1, c, mu_r), k = zmix(Zs, tl + 1, 256 + c, mu_k), v = zmix(Zs, tl + 1, 512 + c, mu_v), kk = k * k_k * inv[tl * 4 + h];
                rv[ct][i] = r; kv[ct][i] = k; kkv[ct][i] = kk;
                ((f16*)(P.ws + WS_RV))[o] = (f16)v; ((f16*)(P.ws + WS_RG))[o] = (f16)ag[ct][i]; } }
    }
    __syncthreads();
    {
        unsigned char* wl = lds + wave * 13952;
        f16* XA = (f16*)wl; f16* XR = XA + 16 * 68; f16* XB = XR + 16 * 68; f16* XK = XB + 16 * 68;
        float* Ew = (float*)(XK + 16 * 68); float* LAs = Ew + 16 * 64; float* bonW = LAs + 16 * 17;
        const int mc = m0 + 16 * rt;
        float kav[4], rkv[4];
        { const float* kap = INP(I_KA) + (size_t)l * DG + 64 * h + fr; const float* rkp = INP(I_RK) + (size_t)l * DG + 64 * h + fr;
#pragma unroll
          for (int ct = 0; ct < 4; ++ct) { kav[ct] = kap[16 * ct]; rkv[ct] = rkp[16 * ct]; } }
#pragma unroll 1
        for (int d = 0; d < 2; ++d) {
            unsigned char* rec = P.ws + WS_RCH + ((size_t)(d * 4 + h) * (M / 16) + mc / 16) * RCH_REC;
            float ev[4][4], kdv[4][4], bv[4][4], bp[4] = {0.f, 0.f, 0.f, 0.f};
            float w0v[4], a0v[4]; pg8::bf16x8 bw[4][2], ba[4][2];
            { const float* w0p = INP(I_W0) + ((size_t)l * 2 + d) * DG + 64 * h + fr; const float* a0p = INP(I_A0) + ((size_t)l * 2 + d) * DG + 64 * h + fr;
#pragma unroll
              for (int ct = 0; ct < 4; ++ct) { w0v[ct] = w0p[16 * ct]; a0v[ct] = a0p[16 * ct];
#pragma unroll
                  for (int ks = 0; ks < 2; ++ks) { const int bo = ((d * 256 + 64 * h + 16 * ct + fr) * 64) + ks * 32 + fq * 8; bw[ct][ks] = *(const pg8::bf16x8*)(SW + SW_WUP + bo); ba[ct][ks] = *(const pg8::bf16x8*)(SW + SW_AUP + bo); } } }
#pragma unroll
            for (int ct = 0; ct < 4; ++ct) {
                pg8::f32x4 aw = {0.f, 0.f, 0.f, 0.f}, aa = {0.f, 0.f, 0.f, 0.f};
#pragma unroll
                for (int ks = 0; ks < 2; ++ks) {
                    aw = mfma16(*(const pg8::bf16x8*)(LRw + (16 * rt + fr) * 72 + ks * 32 + fq * 8), bw[ct][ks], aw);
                    aa = mfma16(*(const pg8::bf16x8*)(LRa + (16 * rt + fr) * 72 + ks * 32 + fq * 8), ba[ct][ks], aa); }
                const float w0 = w0v[ct], a0 = a0v[ct], k_a = kav[ct], r_k = rkv[ct];
#pragma unroll
                for (int i = 0; i < 4; ++i) { const float e = fexp(-softplus_(-(w0 + aw[i])) - 0.5f), a = sigm(a0 + aa[i]);
                    ev[ct][i] = e; kdv[ct][i] = kv[ct][i] * (1.f + (a - 1.f) * k_a); bv[ct][i] = kkv[ct][i] * a; bp[i] += rv[ct][i] * kdv[ct][i] * r_k;
                    Ew[(4 * fq + i) * 64 + 16 * ct + fr] = e; } }
#pragma unroll
            for (int i = 0; i < 4; ++i) { const float bs = sum16(bp[i]); const int tok = 4 * fq + i; if (fr == 0) bonW[d ? 15 - tok : tok] = bs; }
            __syncthreads();
            {
                float cum = 0.f;
#pragma unroll
                for (int pos = 0; pos < 16; ++pos) { const int tok = d ? 15 - pos : pos; const float x = Ew[tok * 64 + lane]; Ew[tok * 64 + lane] = cum; cum += x; }
                ((float*)(rec + 10240))[lane] = fexp(-cum);
            }
            __syncthreads();
#pragma unroll
            for (int ct = 0; ct < 4; ++ct)
#pragma unroll
                for (int i = 0; i < 4; ++i) { const int tok = 4 * fq + i, k = 16 * ct + fr, pos = d ? 15 - tok : tok; const float cb = Ew[tok * 64 + k], e = ev[ct][i];
                    const float wm1 = fexp(-cb), iw = fexp(cb + e), wt = fexp(-(cb + e));
                    const f16 al = (f16)(kkv[ct][i] * wm1), rh = (f16)(rv[ct][i] * wt), be = (f16)(bv[ct][i] * iw), ka = (f16)(kdv[ct][i] * iw);
                    XA[pos * 68 + k] = al; XR[pos * 68 + k] = rh; XB[pos * 68 + k] = be; XK[pos * 68 + k] = ka;
                    { const int o = pos * 64 + ((((k >> 3) ^ (pos >> 1)) & 7) << 3) + (k & 7); ((f16*)rec)[o] = al; ((f16*)(rec + 2048))[o] = rh; } }
            __syncthreads();
            {
                typedef f16 h8v __attribute__((ext_vector_type(8)));
                h8v b0, b1, k0, k1;
#pragma unroll
                for (int sx = 0; sx < 8; ++sx) { b0[sx] = XB[sx * 68 + lane]; b1[sx] = XB[(8 + sx) * 68 + lane]; k0[sx] = XK[sx * 68 + lane]; k1[sx] = XK[(8 + sx) * 68 + lane]; }
                { const int sw = ((lane >> 3) & 1) * 16; *(h8v*)(rec + 4096 + lane * 32 + sw) = b0; *(h8v*)(rec + 4096 + lane * 32 + (sw ^ 16)) = b1; *(h8v*)(rec + 6144 + lane * 32 + sw) = k0; *(h8v*)(rec + 6144 + lane * 32 + (sw ^ 16)) = k1; }
            }
            {
                pg8::f32x4 la = {0.f, 0.f, 0.f, 0.f}, lb = la, ma = la, mb = la;
#pragma unroll
                for (int j = 0; j < 4; ++j) { const h4 xa = *(const h4*)(XA + fr * 68 + 16 * j + 4 * fq), xr = *(const h4*)(XR + fr * 68 + 16 * j + 4 * fq), xb = *(const h4*)(XB + fr * 68 + 16 * j + 4 * fq), xk = *(const h4*)(XK + fr * 68 + 16 * j + 4 * fq);
                    la = mfma16h(xa, xb, la); lb = mfma16h(xa, xk, lb); ma = mfma16h(xr, xb, ma); mb = mfma16h(xr, xk, mb); }
#pragma unroll
                for (int i = 0; i < 4; ++i) { const int t = 4 * fq + i, sx = fr;
                    LAs[t * 17 + sx] = sx < t ? la[i] : 0.f;
                    const int mo = t * 16 + ((((sx >> 3) ^ (t >> 3)) & 1) << 3) + (sx & 7);
                    ((f16*)(rec + 8192))[mo] = (f16)(sx < t ? lb[i] : 0.f);
                    ((f16*)(rec + 9216))[mo] = (f16)(sx <= t ? ma[i] : 0.f);
                    ((f16*)(rec + 9728))[mo] = (f16)((sx <= t ? mb[i] : 0.f) + (sx == t ? bonW[t] : 0.f)); }
            }
            __syncthreads();
            {
                const int col = lane & 15; float tc[16];
#pragma unroll
                for (int t = 0; t < 16; ++t) { float x = (t == col) ? 1.f : 0.f;
#pragma unroll
                    for (int sx = 0; sx < t; ++sx) x -= LAs[t * 17 + sx] * tc[sx];
                    tc[t] = x; }
                if (lane < 16) {
#pragma unroll
                    for (int t = 0; t < 16; ++t) ((f16*)(rec + 8704))[t * 16 + ((((col >> 3) ^ (t >> 3)) & 1) << 3) + (col & 7)] = (f16)(-tc[t]); }
            }
            __syncthreads();
        }
    }
}
DEV void phase_rwkv_prep(const Params& P, int l, unsigned char* lds) { for (int it = blockIdx.x; it < M / 32; it += gridDim.x) rwkv_prep_item(P, l, it, lds); }

constexpr int CS_STAGE = 4 * RCH_REC + 4 * 2048;
struct CsEarly { h4 al[4], rh[4], lb, vop; };
struct CsLate { h4 bt[4], kt[4], nt, ma, mb; pg8::f32x4 wc[4]; };
DEV CsEarly cs_load_early(const unsigned char* im, const unsigned char* vim, int fr, int fq, int vcol2, int d) {
    CsEarly o; const int h8 = 8 * (fq & 1), mx = (((fq >> 1) ^ (fr >> 3)) & 1) << 4;
#pragma unroll
    for (int j = 0; j < 4; ++j) { const int go = fr * 128 + ((((2 * j + (fq >> 1)) ^ (fr >> 1)) & 7) << 4) + h8; o.al[j] = *(const h4*)(im + go); o.rh[j] = *(const h4*)(im + 2048 + go); }
    o.lb = *(const h4*)(im + 8192 + fr * 32 + mx + h8);
#pragma unroll
    for (int jj = 0; jj < 4; ++jj) { const int sx = 4 * fq + jj, tok = d ? 15 - sx : sx; o.vop[jj] = *(const f16*)(vim + tok * 128 + vcol2); }
    return o;
}
DEV CsLate cs_load_late(const unsigned char* im, int fr, int fq) {
    CsLate o; const int h8 = 8 * (fq & 1), mx = (((fq >> 1) ^ (fr >> 3)) & 1) << 4;
#pragma unroll
    for (int j = 0; j < 4; ++j) { o.bt[j] = *(const h4*)(im + 4096 + (16 * j + fr) * 32 + mx + h8); o.kt[j] = *(const h4*)(im + 6144 + (16 * j + fr) * 32 + mx + h8); o.wc[j] = *(const pg8::f32x4*)(im + 10240 + (16 * j + 4 * fq) * 4); }
    o.nt = *(const h4*)(im + 8704 + fr * 32 + mx + h8); o.ma = *(const h4*)(im + 9216 + fr * 32 + mx + h8); o.mb = *(const h4*)(im + 9728 + fr * 32 + mx + h8);
    return o;
}
#ifdef CPU_EMU
#define SCHED_FENCE()
#define WAVE_UNIFORM(x) (x)
#else
#define SCHED_FENCE() __builtin_amdgcn_sched_barrier(0)
#define WAVE_UNIFORM(x) __builtin_amdgcn_readfirstlane(x)
#endif
DEV void rwkv_chunk_scan_item(const Params& P, int l, int chain, unsigned char* lds) {
    const int tid = TID(), lane = tid & 63, wave = WAVE_UNIFORM(tid >> 6), fr = lane & 15, fq = lane >> 4;
    const int d = chain & 1, h = (chain >> 1) & 3, sq = chain >> 3;
    const bool lat = sq >= BATCH;
    const int T = lat ? DEC_SEQ : SEQ, base = lat ? M_CTX + (sq - BATCH) * DEC_SEQ : sq * SEQ;
    const unsigned char* RCH = P.ws + WS_RCH + (size_t)(d * 4 + h) * (M / 16) * RCH_REC;
    const unsigned char* RVb = P.ws + WS_RV + (size_t)h * 128;
    f16* RY = (f16*)(P.ws + WS_RY) + (size_t)d * M * DG;
    const bool scanner = wave < 4; const int vs = 16 * wave;
    pg8::f32x4 S[4];
    if (scanner && lat) { const float* si = INP(I_SRWKV) + ((((size_t)(sq - BATCH) * DEPTH + l) * 2 + d) * 4 + h) * 4096 + (size_t)(vs + fr) * 64 + 4 * fq;
#pragma unroll
        for (int j = 0; j < 4; ++j) S[j] = *(const pg8::f32x4*)(si + 16 * j); }
    else {
#pragma unroll
        for (int j = 0; j < 4; ++j) S[j] = (pg8::f32x4){0.f, 0.f, 0.f, 0.f}; }
    const int lt = tid - 256;
    pg8::u32x4 gA[13], gB[13];
#define CS_GLOAD(G_, st) do { const int c0_ = d ? (T / 16 - 4 - 4 * (st)) : 4 * (st); const unsigned char* rs_ = RCH + (size_t)(base / 16 + c0_) * RCH_REC + lt * 16; \
        _Pragma("unroll") for (int r_ = 0; r_ < 11; ++r_) if (r_ < 10 || lt < 64) G_[r_] = *(const pg8::u32x4*)(rs_ + r_ * 4096); \
        const unsigned char* vs_ = RVb + (size_t)(base + 16 * c0_ + (lt >> 3)) * 512 + (lt & 7) * 16; \
        G_[11] = *(const pg8::u32x4*)vs_; G_[12] = *(const pg8::u32x4*)(vs_ + 32 * 512); } while (0)
#define CS_LSTORE(G_, bb) do { unsigned char* ld_ = lds + (bb) * CS_STAGE + lt * 16; \
        _Pragma("unroll") for (int r_ = 0; r_ < 11; ++r_) if (r_ < 10 || lt < 64) *(pg8::u32x4*)(ld_ + r_ * 4096) = G_[r_]; \
        *(pg8::u32x4*)(ld_ + 4 * RCH_REC) = G_[11]; *(pg8::u32x4*)(ld_ + 4 * RCH_REC + 4096) = G_[12]; } while (0)
#define CS_COMPUTE(st) do { { const unsigned char* im0 = lds + ((st) & 1) * CS_STAGE; \
            const unsigned char* vm0 = im0 + 4 * RCH_REC; \
            CsEarly cur = cs_load_early(im0 + (d ? 3 : 0) * RCH_REC, vm0 + (d ? 3 : 0) * 2048, fr, fq, (vs + fr) * 2, d); \
            _Pragma("unroll") for (int q = 0; q < 4; ++q) { \
                const CsLate lt_ = cs_load_late(im0 + (d ? 3 - q : q) * RCH_REC, fr, fq); \
                CsEarly nxt = cur; if (q < 3) nxt = cs_load_early(im0 + (d ? 2 - q : q + 1) * RCH_REC, vm0 + (d ? 2 - q : q + 1) * 2048, fr, fq, (vs + fr) * 2, d); \
                SCHED_FENCE(); \
                const int ck = d ? (T / 16 - 1 - (4 * (st) + q)) : 4 * (st) + q; \
                h4 s16[4]; \
                _Pragma("unroll") for (int j = 0; j < 4; ++j) s16[j] = cvt_h4(S[j]); \
                pg8::f32x4 dd = {0.f, 0.f, 0.f, 0.f}, yy = {0.f, 0.f, 0.f, 0.f}; \
                _Pragma("unroll") for (int j = 0; j < 4; ++j) dd = mfma16h(cur.al[j], s16[j], dd); \
                dd = mfma16h(cur.lb, cur.vop, dd); \
                _Pragma("unroll") for (int j = 0; j < 4; ++j) yy = mfma16h(cur.rh[j], s16[j], yy); \
                yy = mfma16h(lt_.mb, cur.vop, yy); \
                const h4 e16 = cvt_h4(dd); \
                const pg8::f32x4 pp = mfma16h(lt_.nt, e16, (pg8::f32x4){0.f, 0.f, 0.f, 0.f}); \
                _Pragma("unroll") for (int j = 0; j < 4; ++j) S[j] = mfma16h(lt_.kt[j], cur.vop, S[j]); \
                const h4 p16 = cvt_h4(pp); \
                _Pragma("unroll") for (int j = 0; j < 4; ++j) S[j] = mfma16h(lt_.bt[j], p16, S[j]); \
                yy = mfma16h(lt_.ma, p16, yy); \
                _Pragma("unroll") for (int j = 0; j < 4; ++j) S[j] = S[j] * lt_.wc[j]; \
                f16* yp_ = RY + (size_t)(base + 16 * ck) * DG + h * 64 + vs + fr; \
                _Pragma("unroll") for (int i = 0; i < 4; ++i) { const int sx = 4 * fq + i, tok = d ? 15 - sx : sx; yp_[tok * DG] = (f16)yy[i]; } \
                cur = nxt; \
            } } } while (0)
    const int nst = T / 64;
    __syncthreads();
    if (!scanner) {
        CS_GLOAD(gA, 0); CS_LSTORE(gA, 0); if (nst > 1) CS_GLOAD(gB, 1); if (nst > 2) CS_GLOAD(gA, 2);
        __syncthreads();
        for (int st = 0; st < nst; st += 2) {
            if (st + 1 < nst) CS_LSTORE(gB, 1);
            if (st + 3 < nst) CS_GLOAD(gB, st + 3);
            __syncthreads();
            if (st + 1 >= nst) break;
            if (st + 2 < nst) CS_LSTORE(gA, 0);
            if (st + 4 < nst) CS_GLOAD(gA, st + 4);
            __syncthreads();
        }
    } else {
        __syncthreads();
        for (int st = 0; st < nst; ++st) { CS_COMPUTE(st); __syncthreads(); }
    }
#undef CS_GLOAD
#undef CS_LSTORE
#undef CS_COMPUTE
    if (!lat && scanner) { float* so = P.out + (size_t)M * D + ((((size_t)sq * DEPTH + l) * 2 + d) * 4 + h) * 4096 + (size_t)(vs + fr) * 64 + 4 * fq;
#pragma unroll
        for (int j = 0; j < 4; ++j) *(pg8::f32x4*)(so + 16 * j) = S[j]; }
}

DEV void unpack8(pg8::u32x4 v, float (&o)[8]) {
#pragma unroll
    for (int j = 0; j < 4; ++j) { o[2 * j] = __builtin_bit_cast(float, v[j] << 16); o[2 * j + 1] = __builtin_bit_cast(float, v[j] & 0xffff0000u); }
}
DEV void mlstm_load_kv(const Params& P, int l, const bf16_t* Z, const SeqInfo& s0, int h, bf16_t* Qs, bf16_t* Ks, bf16_t* KTs, bf16_t* VTs, int tid) {
    const float* cw = INP(I_QKCONV) + (size_t)l * 3 * 512;
    const int i = tid >> 3, c8 = (tid & 7) * 8, t = s0.t + i;
    pg8::u32x4 zq[3], zk[3]; float msk[3];
#pragma unroll
    for (int j = 0; j < 3; ++j) { const int tt = t + j - 1, tc = tt < 0 ? 0 : (tt >= s0.T ? s0.T - 1 : tt); msk[j] = (tt >= 0 && tt < s0.T) ? 1.f : 0.f;
        const bf16_t* zr = Z + ((size_t)s0.base + tc) * ZW + ZD + h * 64 + c8; if (Qs) zq[j] = *(const pg8::u32x4*)zr; zk[j] = *(const pg8::u32x4*)(zr + 256); }
    const pg8::u32x4 zv = *(const pg8::u32x4*)(Z + ((size_t)s0.base + t) * ZW + ZD_V + h * 64 + c8);
    float aq[8], ak[8];
#pragma unroll
    for (int e = 0; e < 8; ++e) { aq[e] = 0.f; ak[e] = 0.f; }
#pragma unroll
    for (int j = 0; j < 3; ++j) { float xq[8], xk[8]; if (Qs) unpack8(zq[j], xq); unpack8(zk[j], xk);
        const float* wq = cw + j * 512 + h * 64 + c8; const pg8::f32x4 wk0 = *(const pg8::f32x4*)(wq + 256), wk1 = *(const pg8::f32x4*)(wq + 260);
#pragma unroll
        for (int e = 0; e < 8; ++e) ak[e] += xk[e] * (e < 4 ? wk0[e] : wk1[e - 4]) * msk[j];
        if (Qs) { const pg8::f32x4 wq0 = *(const pg8::f32x4*)wq, wq1 = *(const pg8::f32x4*)(wq + 4);
#pragma unroll
            for (int e = 0; e < 8; ++e) aq[e] += xq[e] * (e < 4 ? wq0[e] : wq1[e - 4]) * msk[j]; } }
    pg8::u32x4 kb;
#pragma unroll
    for (int e = 0; e < 4; ++e) kb[e] = pk2(silu_(ak[2 * e]) * 0.125f, silu_(ak[2 * e + 1]) * 0.125f);
    if (Qs) { pg8::u32x4 qb;
#pragma unroll
        for (int e = 0; e < 4; ++e) qb[e] = pk2(silu_(aq[2 * e]), silu_(aq[2 * e + 1]));
        *(pg8::u32x4*)(Qs + i * LT + c8) = qb; *(pg8::u32x4*)(Ks + i * LT + c8) = kb; }
#pragma unroll
    for (int e = 0; e < 8; ++e) { const bf16_t kv = (bf16_t)(kb[e >> 1] >> (16 * (e & 1))), vv = (bf16_t)(zv[e >> 1] >> (16 * (e & 1)));
        if (KTs) KTs[(c8 + e) * LT + i] = kv;
        VTs[(c8 + e) * LT + i] = vv; }
}
DEV void mlstm_local_item(const Params& P, int l, int it, unsigned char* lds) {
    const int tid = TID(), lane = tid & 63, wave = tid >> 6, fr = lane & 15, fq = lane >> 4;
    const int tcg = it >> 2, h = it & 3, m0 = tcg * 64; const SeqInfo s0 = seq_of(m0);
    const bf16_t* Z = (const bf16_t*)(P.ws + WS_Z);
    bf16_t* KTs = (bf16_t*)lds; bf16_t* VTs = KTs + 64 * LT; bf16_t* VWs = VTs + 64 * LT;
    float* li = (float*)(VWs + 2 * 64 * LT); float* lf = li + 128; float* wend = lf + 128;
    __syncthreads();
    mlstm_load_kv(P, l, Z, s0, h, nullptr, nullptr, KTs, VTs, tid);
    if (tid < 128) { const int d = tid >> 6, i = tid & 63; const size_t m = (size_t)m0 + i;
        li[tid] = bf2f(Z[m * ZW + ZD_I + d * 4 + h]) + INP(I_IB)[(size_t)l * 8 + d * 4 + h]; lf[tid] = -softplus_(-(bf2f(Z[m * ZW + ZD_F + d * 4 + h]) + INP(I_FB)[(size_t)l * 8 + d * 4 + h])); }
    __syncthreads();
    if (wave < 2) { const int d = wave, tok = d ? 63 - lane : lane;
        const float b = wave_incl_sum(lf[d * 64 + tok], lane), a = li[d * 64 + tok] - b;
        const float amax = lane_get(wave_incl_max(a, lane), 63), btot = lane_get(b, 63);
        wend[d * 64 + tok] = fexp(a - amax);
        if (lane == 0) { float* ab = (float*)(P.ws + WS_AB) + (((size_t)d * NTC + tcg) * 4 + h) * 2; ab[0] = btot + amax; ab[1] = btot; } }
    __syncthreads();
#pragma unroll
    for (int r = 0; r < 16; ++r) { const int e = tid + 512 * r, d = e >> 12, v = (e >> 6) & 63, sx = e & 63; VWs[(d * 64 + v) * LT + sx] = f2bf(wend[d * 64 + sx] * bf2f(VTs[v * LT + sx])); }
    if (tid < 128) { const int d = tid >> 6, k = tid & 63; float a = 0.f; for (int sx = 0; sx < 64; ++sx) a += wend[d * 64 + sx] * bf2f(KTs[k * LT + sx]);
        ((float*)(P.ws + WS_NU))[(((size_t)d * NTC + tcg) * 4 + h) * 64 + k] = a; }
    __syncthreads();
    {
        const int d = wave >> 2, tr = wave & 3; f16* up = (f16*)(P.ws + WS_UP) + (((size_t)d * NTC + tcg) * 4 + h) * 4096;
#pragma unroll
        for (int tc = 0; tc < 4; ++tc) { const pg8::f32x4 acc = tile_mm64(VWs + d * 64 * LT, 16 * tr, KTs, 16 * tc, fr, fq);
#pragma unroll
            for (int i = 0; i < 4; ++i) up[(16 * tr + 4 * fq + i) * 64 + 16 * tc + fr] = (f16)acc[i]; }
    }
}
typedef f16 h8 __attribute__((ext_vector_type(8)));
DEV void mlstm_state_item(const Params& P, int l, int chain, unsigned char* lds) {
    const int tid = TID();
    const int d = chain & 1, h = (chain >> 1) & 3, sq = chain >> 3;
    const bool lat = sq >= BATCH;
    const int T = lat ? DEC_SEQ : SEQ, base = lat ? M_CTX + (sq - BATCH) * DEC_SEQ : sq * SEQ, nc = T / 64, tc0 = base / 64;
    float C[8], n = 0.f, m = 0.f;
    if (lat) { const size_t sb = ((((size_t)(sq - BATCH) * DEPTH + l) * 2 + d) * 4 + h); const float* c0 = INP(I_SC) + sb * 4096 + tid * 8;
#pragma unroll
        for (int j = 0; j < 8; ++j) C[j] = c0[j];
        if (tid < 64) n = INP(I_SN)[sb * 64 + tid];
        m = INP(I_SM)[sb]; }
    else {
#pragma unroll
        for (int j = 0; j < 8; ++j) C[j] = 0.f; }
    const f16* UP = (const f16*)(P.ws + WS_UP); f16* CP = (f16*)(P.ws + WS_CP);
    const float* NU = (const float*)(P.ws + WS_NU); float* NP = (float*)(P.ws + WS_NP); const float* AB = (const float*)(P.ws + WS_AB); float* MP = (float*)(P.ws + WS_MP);
    size_t ix = ((size_t)d * NTC + tc0 + (d ? nc - 1 : 0)) * 4 + h; const long dix = d ? -4 : 4;
    h8 u = *(const h8*)(UP + ix * 4096 + tid * 8); float nu = tid < 64 ? NU[ix * 64 + tid] : 0.f; float ac = AB[ix * 2], bc = AB[ix * 2 + 1];
    for (int ci = 0; ci < nc; ++ci) {
        const size_t cx = ix; const h8 uc = u; const float nuc = nu, acc_ = ac, bcc = bc;
        if (ci + 1 < nc) { ix += dix; u = *(const h8*)(UP + ix * 4096 + tid * 8); nu = tid < 64 ? NU[ix * 64 + tid] : 0.f; ac = AB[ix * 2]; bc = AB[ix * 2 + 1]; }
        h8 cp;
#pragma unroll
        for (int j = 0; j < 8; ++j) cp[j] = (f16)C[j];
        *(h8*)(CP + cx * 4096 + tid * 8) = cp;
        if (tid < 64) NP[cx * 64 + tid] = n;
        if (tid == 0) MP[cx] = m;
        const float mn = fmaxf(m + bcc, acc_), cd = fexp(m + bcc - mn), cu = fexp(acc_ - mn);
#pragma unroll
        for (int j = 0; j < 8; ++j) C[j] = cd * C[j] + cu * (float)uc[j];
        n = cd * n + cu * nuc; m = mn;
    }
    if (!lat) {
        const size_t sb = ((((size_t)sq * DEPTH + l) * 2 + d) * 4 + h);
        float* oc = P.out + (size_t)M * D + (size_t)BATCH * DEPTH * 8 * 4096 + sb * 4096 + tid * 8;
#pragma unroll
        for (int j = 0; j < 8; ++j) oc[j] = C[j];
        if (tid < 64) P.out[(size_t)M * D + (size_t)2 * BATCH * DEPTH * 8 * 4096 + sb * 64 + tid] = n;
        if (tid == 0) P.out[(size_t)M * D + (size_t)2 * BATCH * DEPTH * 8 * 4096 + (size_t)BATCH * DEPTH * 8 * 64 + sb] = m;
    }
}
DEV void mlstm_out_item(const Params& P, int l, int it, unsigned char* lds) {
    const int tid = TID(), lane = tid & 63, wave = tid >> 6, fr = lane & 15, fq = lane >> 4;
    const int tcg = it >> 2, h = it & 3, m0 = tcg * 64; const SeqInfo s0 = seq_of(m0);
    const bf16_t* Z = (const bf16_t*)(P.ws + WS_Z);
    bf16_t* Y = (bf16_t*)(P.ws + WS_H);
    bf16_t* Qs = (bf16_t*)lds; bf16_t* Ks = Qs + 64 * LT; bf16_t* VTs = Ks + 64 * LT; bf16_t* Ss = VTs + 64 * LT; bf16_t* Cs = Ss + 2 * 64 * LT;
    float* li = (float*)(Cs + 2 * 64 * LT); float* lf = li + 128; float* bc = lf + 128; float* ml = bc + 128; float* e1 = ml + 128; float* e2 = e1 + 128; float* fl = e2 + 128; float* np = fl + 128;
    float* mp = np + 128; float* Hs = mp + 4;
    __syncthreads();
    mlstm_load_kv(P, l, Z, s0, h, Qs, Ks, nullptr, VTs, tid);
    if (tid < 128) { const int d = tid >> 6, i = tid & 63; const size_t m = (size_t)m0 + i;
        li[tid] = bf2f(Z[m * ZW + ZD_I + d * 4 + h]) + INP(I_IB)[(size_t)l * 8 + d * 4 + h]; lf[tid] = -softplus_(-(bf2f(Z[m * ZW + ZD_F + d * 4 + h]) + INP(I_FB)[(size_t)l * 8 + d * 4 + h]));
        np[tid] = ((const float*)(P.ws + WS_NP))[(((size_t)d * NTC + tcg) * 4 + h) * 64 + i]; }
    if (tid < 2) mp[tid] = ((const float*)(P.ws + WS_MP))[((size_t)tid * NTC + tcg) * 4 + h];
#pragma unroll
    for (int r = 0; r < 2; ++r) { const int e = (tid + 512 * r) * 8, d = e >> 12, v = (e >> 6) & 63, k = e & 63;
        const h8 c = *(const h8*)((const f16*)(P.ws + WS_CP) + (((size_t)d * NTC + tcg) * 4 + h) * 4096 + (e & 4095));
        pg8::u32x4 w; w.x = pk2((float)c[0], (float)c[1]); w.y = pk2((float)c[2], (float)c[3]); w.z = pk2((float)c[4], (float)c[5]); w.w = pk2((float)c[6], (float)c[7]);
        *(pg8::u32x4*)(Cs + (d * 64 + v) * LT + k) = w; }
    __syncthreads();
    if (wave < 2) { const int d = wave, x = d * 64 + (d ? 63 - lane : lane); const float m_prev = mp[d];
        const float b = wave_incl_sum(lf[x], lane), run = wave_incl_max(li[x] - b, lane), mloc = b + run, mt = fmaxf(b + m_prev, mloc);
        bc[x] = b; ml[x] = mloc; e1[x] = fexp(mloc - mt); e2[x] = fexp(b + m_prev - mt); fl[x] = fexp(-mt); }
    __syncthreads();
    {
        const int tr = wave >> 1;
#pragma unroll
        for (int cc = 0; cc < 2; ++cc) { const int tc = 2 * (wave & 1) + cc; const pg8::f32x4 acc = tile_mm64(Qs, 16 * tr, Ks, 16 * tc, fr, fq); const int sx = 16 * tc + fr;
#pragma unroll
            for (int i = 0; i < 4; ++i) { const int t = 16 * tr + 4 * fq + i;
#pragma unroll
                for (int d = 0; d < 2; ++d) { const bool ok = d ? sx >= t : sx <= t; const float w = ok ? fexp(bc[d * 64 + t] - bc[d * 64 + sx] + li[d * 64 + sx] - ml[d * 64 + t]) : 0.f;
                    Ss[(d * 64 + t) * LT + sx] = f2bf(acc[i] * w); } } }
    }
    __syncthreads();
    const int d = wave >> 2, tr = wave & 3;
    float hreg[4][4];
    {
        float den[4], nq[4];
#pragma unroll
        for (int i = 0; i < 4; ++i) { const int t = 16 * tr + 4 * fq + i; float a = 0.f, b = 0.f;
#pragma unroll
            for (int j = 0; j < 4; ++j) { a += bf2f(Ss[(d * 64 + t) * LT + fr * 4 + j]); b += np[d * 64 + fr * 4 + j] * bf2f(Qs[t * LT + fr * 4 + j]); }
            den[i] = sum16(a); nq[i] = sum16(b); }
#pragma unroll
        for (int tc = 0; tc < 4; ++tc) { const pg8::f32x4 num = tile_mm64(Ss + d * 64 * LT, 16 * tr, VTs, 16 * tc, fr, fq), cq = tile_mm64(Qs, 16 * tr, Cs + d * 64 * LT, 16 * tc, fr, fq);
#pragma unroll
            for (int i = 0; i < 4; ++i) { const int x = d * 64 + 16 * tr + 4 * fq + i; const float dn = fmaxf(fabsf(e1[x] * den[i] + e2[x] * nq[i]), fl[x]);
                hreg[tc][i] = (e1[x] * num[i] + e2[x] * cq[i]) / dn; } }
    }
    if (d == 1) {
#pragma unroll
        for (int tc = 0; tc < 4; ++tc)
#pragma unroll
            for (int i = 0; i < 4; ++i) Hs[(16 * tr + 4 * fq + i) * 65 + 16 * tc + fr] = hreg[tc][i]; }
    __syncthreads();
    if (d == 0) {
        float ss[4] = {0.f, 0.f, 0.f, 0.f};
#pragma unroll
        for (int tc = 0; tc < 4; ++tc)
#pragma unroll
            for (int i = 0; i < 4; ++i) { const int t = 16 * tr + 4 * fq + i, v = 16 * tc + fr; const float op = bf2f(Z[(size_t)(m0 + t) * ZW + ZD_O + h * 64 + v]);
                const float x = (hreg[tc][i] + Hs[t * 65 + v]) * sigm(op); hreg[tc][i] = x; ss[i] += x * x; }
#pragma unroll
        for (int i = 0; i < 4; ++i) ss[i] = frsq(sum16(ss[i]) * (1.f / 64.f) + 1e-6f);
#pragma unroll
        for (int tc = 0; tc < 4; ++tc) { const float g = INP(I_HNG)[(size_t)l * DG + h * 64 + 16 * tc + fr];
#pragma unroll
            for (int i = 0; i < 4; ++i) Y[(size_t)(m0 + 16 * tr + 4 * fq + i) * D + 768 + h * 64 + 16 * tc + fr] = f2bf(hreg[tc][i] * ss[i] * g); }
    }
}

DEV void conv_item(const Params& P, int l, int it, unsigned char* lds) {
    const int tid = TID(), c = tid & 255, tg = tid >> 8, lane = tid & 63, wave = tid >> 6, fr = lane & 15, fq = lane >> 4;
    const bf16_t* Z = (const bf16_t*)(P.ws + WS_Z);
    bf16_t* Y = (bf16_t*)(P.ws + WS_H);
    float* u = (float*)lds;
    float* cv = u + 62 * 256;
    float* st = cv + 32 * 256;
    bf16_t* As = (bf16_t*)lds;
    const int m0 = it * 32; const SeqInfo s0 = seq_of(m0);
    __syncthreads();
#pragma unroll
    for (int r = 0; r < 4; ++r) { const int e = tid + 512 * r, rr = e >> 5, c8 = (e & 31) * 8, t = s0.t - 15 + rr, tc = t < 0 ? 0 : (t >= s0.T ? s0.T - 1 : t);
        if (e >= 62 * 32) continue;
        pg8::f32x4 o0 = {0.f, 0.f, 0.f, 0.f}, o1 = {0.f, 0.f, 0.f, 0.f};
        const bf16_t* zr = Z + (size_t)(s0.base + tc) * ZW + ZC + c8; const pg8::u32x4 va = *(const pg8::u32x4*)zr, ga = *(const pg8::u32x4*)(zr + 256);
        if (t == tc) {
#pragma unroll
            for (int j = 0; j < 4; ++j) { const float v0 = __builtin_bit_cast(float, va[j] << 16), v1 = __builtin_bit_cast(float, va[j] & 0xffff0000u), g0 = __builtin_bit_cast(float, ga[j] << 16), g1 = __builtin_bit_cast(float, ga[j] & 0xffff0000u);
                const float a = v0 * sigm(g0), b = v1 * sigm(g1); if (j < 2) { o0[2 * j] = a; o0[2 * j + 1] = b; } else { o1[2 * j - 4] = a; o1[2 * j - 3] = b; } } }
        *(pg8::f32x4*)(u + rr * 256 + c8) = o0; *(pg8::f32x4*)(u + rr * 256 + c8 + 4) = o1; }
    __syncthreads();
    {
        float dw[31];
#pragma unroll
        for (int j = 0; j < 31; ++j) dw[j] = INP(I_CDW)[((size_t)l * 31 + j) * DG + c];
        const float cb = INP(I_CB)[(size_t)l * DG + c];
#pragma unroll 4
        for (int tt = 0; tt < 16; ++tt) { const int tl = tg * 16 + tt; float a = cb;
#pragma unroll
            for (int j = 0; j < 31; ++j) a += u[(tl + j) * 256 + c] * dw[j];
            cv[tl * 256 + c] = a; }
    }
    __syncthreads();
#pragma unroll
    for (int r = 0; r < 4; ++r) { const int tl = wave * 4 + r; float x[4]; float sm = 0.f;
#pragma unroll
        for (int j = 0; j < 4; ++j) { x[j] = cv[tl * 256 + lane + 64 * j]; sm += x[j]; }
        const float mean = wave_sum(sm) * (1.f / 256.f); float q2 = 0.f;
#pragma unroll
        for (int j = 0; j < 4; ++j) { const float dd = x[j] - mean; q2 += dd * dd; }
        const float var = wave_sum(q2) * (1.f / 256.f);
        if (lane == 0) { st[tl * 2] = mean; st[tl * 2 + 1] = frsq(var + 1e-5f); } }
    __syncthreads();
    {
        const float lg = INP(I_CLNG)[(size_t)l * DG + c], lb = INP(I_CLNB)[(size_t)l * DG + c];
#pragma unroll
        for (int tt = 0; tt < 16; ++tt) { const int tl = tg * 16 + tt; As[tl * 264 + c] = f2bf(silu_((cv[tl * 256 + c] - st[tl * 2]) * st[tl * 2 + 1] * lg + lb)); }
    }
    __syncthreads();
    {
        const bf16_t* BT = (const bf16_t*)(P.ws + WS_SW) + (size_t)l * SW_LAYER + SW_CPW;
        pg8::f32x4 acc[2][2];
#pragma unroll
        for (int rt = 0; rt < 2; ++rt)
#pragma unroll
            for (int cc = 0; cc < 2; ++cc) acc[rt][cc] = (pg8::f32x4){0.f, 0.f, 0.f, 0.f};
#pragma unroll
        for (int ks = 0; ks < 8; ++ks) { pg8::bf16x8 a[2], b[2];
#pragma unroll
            for (int rt = 0; rt < 2; ++rt) a[rt] = *(const pg8::bf16x8*)(As + (16 * rt + fr) * 264 + ks * 32 + fq * 8);
#pragma unroll
            for (int cc = 0; cc < 2; ++cc) b[cc] = *(const pg8::bf16x8*)(BT + (size_t)(32 * wave + 16 * cc + fr) * 256 + ks * 32 + fq * 8);
#pragma unroll
            for (int rt = 0; rt < 2; ++rt)
#pragma unroll
                for (int cc = 0; cc < 2; ++cc) acc[rt][cc] = mfma16(a[rt], b[cc], acc[rt][cc]); }
#pragma unroll
        for (int rt = 0; rt < 2; ++rt)
#pragma unroll
            for (int cc = 0; cc < 2; ++cc)
#pragma unroll
                for (int i = 0; i < 4; ++i) Y[(size_t)(m0 + 16 * rt + 4 * fq + i) * D + 512 + 32 * wave + 16 * cc + fr] = f2bf(acc[rt][cc][i]);
    }
}

DEV void pool_item(const Params& P, int l, int it, unsigned char* lds) {
    const int tid = TID(), lane = tid & 63, wave = tid >> 6, fr = lane & 15, fq = lane >> 4;
    const bf16_t* Z = (const bf16_t*)(P.ws + WS_Z);
    bf16_t* Y = (bf16_t*)(P.ws + WS_H);
    float* ext = (float*)lds;
    bf16_t* As = (bf16_t*)(ext + 96 * 64);
    const int tile = it >> 2, gi = it & 3, hw = 1 << gi;
    const int m0 = tile * 64; const SeqInfo s0 = seq_of(m0);
    const int zc = ZB + gi * 64, x = tid >> 3, c8 = (tid & 7) * 8;
    __syncthreads();
    int nrows = 1;
    if (s0.lat) {
        const int rr = s0.t / 64, r_lo = rr - hw > 0 ? rr - hw : 0, r_hi = rr + hw < GRID_ROWS ? rr + hw : GRID_ROWS; nrows = r_hi - r_lo;
        float a[8];
#pragma unroll
        for (int j = 0; j < 8; ++j) a[j] = 0.f;
#pragma unroll
        for (int rq = 0; rq < 16; ++rq) { const int r2 = rr - hw + rq, r2c = r2 < 0 ? 0 : (r2 >= GRID_ROWS ? GRID_ROWS - 1 : r2); const bool ok = rq < 2 * hw && r2 == r2c;
            const pg8::u32x4 v = *(const pg8::u32x4*)(Z + (size_t)(s0.base + r2c * 64 + x) * ZW + zc + c8);
#pragma unroll
            for (int j = 0; j < 4; ++j) { a[2 * j] += ok ? __builtin_bit_cast(float, v[j] << 16) : 0.f; a[2 * j + 1] += ok ? __builtin_bit_cast(float, v[j] & 0xffff0000u) : 0.f; } }
        *(pg8::f32x4*)(ext + (16 + x) * 64 + c8) = (pg8::f32x4){a[0], a[1], a[2], a[3]}; *(pg8::f32x4*)(ext + (16 + x) * 64 + c8 + 4) = (pg8::f32x4){a[4], a[5], a[6], a[7]};
    } else {
#pragma unroll
        for (int r = 0; r < 2; ++r) { const int e = tid + 512 * r; if (e >= 96 * 8) continue; const int xr = (e >> 3) - 16, cc = (e & 7) * 8, t = s0.t + xr, tc = t < 0 ? 0 : (t >= s0.T ? s0.T - 1 : t); float a[8];
            const pg8::u32x4 v = *(const pg8::u32x4*)(Z + (size_t)(s0.base + tc) * ZW + zc + cc);
#pragma unroll
            for (int j = 0; j < 4; ++j) { a[2 * j] = t == tc ? __builtin_bit_cast(float, v[j] << 16) : 0.f; a[2 * j + 1] = t == tc ? __builtin_bit_cast(float, v[j] & 0xffff0000u) : 0.f; }
            *(pg8::f32x4*)(ext + (e >> 3) * 64 + cc) = (pg8::f32x4){a[0], a[1], a[2], a[3]}; *(pg8::f32x4*)(ext + (e >> 3) * 64 + cc + 4) = (pg8::f32x4){a[4], a[5], a[6], a[7]}; }
    }
    __syncthreads();
    {
        int lo, hi;
        if (s0.lat) { lo = x - hw > 0 ? x - hw : 0; hi = x + hw < 64 ? x + hw : 64; }
        else { const int t = s0.t + x; lo = (t - hw > 0 ? t - hw : 0) - s0.t; hi = (t + hw < s0.T ? t + hw : s0.T) - s0.t; }
        pg8::f32x4 a0 = {0.f, 0.f, 0.f, 0.f}, a1 = {0.f, 0.f, 0.f, 0.f};
        for (int x2 = lo; x2 < hi; ++x2) { a0 = a0 + *(const pg8::f32x4*)(ext + (16 + x2) * 64 + c8); a1 = a1 + *(const pg8::f32x4*)(ext + (16 + x2) * 64 + c8 + 4); }
        const float sc = 1.f / (float)((hi - lo) * nrows);
        const pg8::u32x4 ov = *(const pg8::u32x4*)(Z + (size_t)(m0 + x) * ZW + zc + c8);
        pg8::u32x4 w;
#pragma unroll
        for (int j = 0; j < 4; ++j) { const float p0 = (j < 2 ? a0[2 * j] : a1[2 * j - 4]) * sc - __builtin_bit_cast(float, ov[j] << 16), p1 = (j < 2 ? a0[2 * j + 1] : a1[2 * j - 3]) * sc - __builtin_bit_cast(float, ov[j] & 0xffff0000u); w[j] = pk2(p0, p1); }
        *(pg8::u32x4*)(As + x * LT + c8) = w;
    }
    __syncthreads();
    {
        const bf16_t* BT = (const bf16_t*)(P.ws + WS_SW) + (size_t)l * SW_LAYER + SW_POOL + gi * 4096;
        const int rt = wave >> 1;
#pragma unroll
        for (int cc = 0; cc < 2; ++cc) { const int ct = 2 * (wave & 1) + cc; pg8::f32x4 acc = {0.f, 0.f, 0.f, 0.f};
#pragma unroll
            for (int ks = 0; ks < 2; ++ks) acc = mfma16(*(const pg8::bf16x8*)(As + (16 * rt + fr) * LT + ks * 32 + fq * 8), *(const pg8::bf16x8*)(BT + (16 * ct + fr) * 64 + ks * 32 + fq * 8), acc);
            const float sc = INP(I_POOLS)[(size_t)l * DG + gi * 64 + 16 * ct + fr];
#pragma unroll
            for (int i = 0; i < 4; ++i) Y[(size_t)(m0 + 16 * rt + 4 * fq + i) * D + 256 + gi * 64 + 16 * ct + fr] = f2bf(acc[i] * sc); }
    }
}

constexpr int N_RW_LAT = DEC_BATCH * 8, N_ML_LAT = DEC_BATCH * 8, N_HEAVY = N_RW_LAT + N_ML_LAT;
constexpr int N_RW_CTX = BATCH * 8, N_ML_CTX = BATCH * 8, N_CONV = M / 32, N_POOL = (M / 64) * 4;
DEV void phase_mixers(const Params& P, int l, unsigned char* lds) {
    const int G = gridDim.x, b = blockIdx.x;
    int r0, r1, rs, q0, q1, qs, c0, cs, p0;
    if (G >= 2 * N_HEAVY) {
        const int nb = G - N_HEAVY, bb = b - N_HEAVY;
        if (b < N_RW_LAT) { r0 = b; r1 = b + 1; rs = 1; q0 = 0; q1 = 0; qs = 1; c0 = N_CONV; cs = 1; p0 = N_POOL; }
        else if (b < N_HEAVY) { r0 = 0; r1 = 0; rs = 1; q0 = b - N_RW_LAT; q1 = q0 + 1; qs = 1; c0 = N_CONV; cs = 1; p0 = N_POOL; }
        else { r0 = N_RW_LAT + bb; r1 = N_RW_LAT + N_RW_CTX; rs = nb; q0 = N_ML_LAT + (bb + nb / 2) % nb; q1 = N_ML_LAT + N_ML_CTX; qs = nb; c0 = (bb + nb / 4) % nb; cs = nb; p0 = (bb + 3 * nb / 4) % nb; }
    } else { r0 = b; r1 = N_RW_LAT + N_RW_CTX; rs = G; q0 = b; q1 = N_ML_LAT + N_ML_CTX; qs = G; c0 = b; cs = G; p0 = b; }
    for (int r = r0; r < r1; r += rs) {
        rwkv_chunk_scan_item(P, l, r < N_RW_LAT ? BATCH * 8 + r : r - N_RW_LAT, lds); }
    for (int q = q0; q < q1; q += qs) { const int ch = q < N_ML_LAT ? BATCH * 8 + q : q - N_ML_LAT; mlstm_state_item(P, l, ch, lds); }
    for (int it = c0; it < N_CONV; it += cs) conv_item(P, l, it, lds);
    for (int it = p0; it < N_POOL; it += cs) pool_item(P, l, it, lds);
}

DEV void phase_finalize(const Params& P, int l) {
    const int tid = TID(), lane = tid & 63, wave = tid >> 6;
    const int gw = blockIdx.x * 8 + wave, NGW = gridDim.x * 8;
    bf16_t* Y = (bf16_t*)(P.ws + WS_H);
    const f16* RY = (const f16*)(P.ws + WS_RY); const f16* RG = (const f16*)(P.ws + WS_RG);
    const int c0 = 4 * lane;
    float lg[4], lb[4];
#pragma unroll
    for (int j = 0; j < 4; ++j) { lg[j] = INP(I_LNG)[(size_t)l * DG + c0 + j]; lb[j] = INP(I_LNB)[(size_t)l * DG + c0 + j]; }
    for (int m = gw; m < M; m += NGW) {
        {
            const h4 a = *(const h4*)(RY + (size_t)m * DG + c0), b = *(const h4*)(RY + ((size_t)M + m) * DG + c0), g = *(const h4*)(RG + (size_t)m * DG + c0);
            float y[4]; float s = 0.f;
#pragma unroll
            for (int j = 0; j < 4; ++j) { y[j] = (float)a[j] + (float)b[j]; s += y[j]; }
            const float mean = sum16(s) * (1.f / 64.f); float q2 = 0.f;
#pragma unroll
            for (int j = 0; j < 4; ++j) { y[j] -= mean; q2 += y[j] * y[j]; }
            const float rs = frsq(sum16(q2) * (1.f / 64.f) + 64e-5f);
            float o[4];
#pragma unroll
            for (int j = 0; j < 4; ++j) o[j] = (y[j] * rs * lg[j] + lb[j]) * (float)g[j];
            *(unsigned long long*)(Y + (size_t)m * D + c0) = (unsigned long long)pk2(o[0], o[1]) | ((unsigned long long)pk2(o[2], o[3]) << 32);
        }
    }
}

constexpr int PH_PER_LAYER = 9, NPHASES = 2 + PH_PER_LAYER * DEPTH;
DEV void run_phase(const Params& P, int ph, unsigned char* lds) {
#ifndef PH_MASK
#define PH_MASK 0xFFFF
#endif
    if (ph == 0) { if (PH_MASK & 0x200) phase_prologue(P, lds); return; }
    if (ph == NPHASES - 1) { if (PH_MASK & 0x400) phase_final(P); return; }
    const int l = (ph - 1) / PH_PER_LAYER, k = (ph - 1) % PH_PER_LAYER;
    const int G = gridDim.x, b = blockIdx.x;
    bool is_gemm = false; pg8::Gemm g{nullptr, nullptr, M, 0, 0}; pg8::EpiAny E{};
    switch (k) {
    case 0: if (!(PH_MASK & (1 << 0))) break; phase_norm(P, l, 0); break;
    case 1: g = pg8::Gemm{(const bf16_t*)(P.ws + WS_H), (const bf16_t*)(P.ws + WS_WIN) + (size_t)l * ZW * D, M, ZW, D};
            E.mode = 0; E.perm = true; E.b0 = pg8::EpiBf16<0>{(bf16_t*)(P.ws + WS_Z), ZW, nullptr}; is_gemm = true; break;
    case 2: phase_rwkv_prep(P, l, lds); for (int it = (b + G / 2) % G; it < NTC * 4; it += G) mlstm_local_item(P, l, it, lds); break;
    case 3: phase_mixers(P, l, lds); break;
    case 4: for (int it = b; it < NTC * 4; it += G) mlstm_out_item(P, l, it, lds); phase_finalize(P, l); break;
    case 5: g = pg8::Gemm{(const bf16_t*)(P.ws + WS_H), (const bf16_t*)(P.ws + WS_WOUT) + (size_t)l * D * D, M, D, D};
            E.mode = 2; E.perm = false; E.rs = pg8::EpiRes{l == 0 ? INP(I_XP) : P.out, l == 0 ? INP(I_XS) : P.out + (size_t)M_CTX * D, P.out, mod_vec(P, l, 0) + 2048, nullptr}; is_gemm = true; break;
    case 6: phase_norm(P, l, 1); break;
    case 7: g = pg8::Gemm{(const bf16_t*)(P.ws + WS_H), (const bf16_t*)(P.ws + WS_W1) + (size_t)l * DFF * D, M, DFF, D};
            E.mode = 1; E.perm = true; E.b1 = pg8::EpiBf16<1>{(bf16_t*)(P.ws + WS_OV), DFF, INP(I_B1) + (size_t)l * DFF}; is_gemm = true; break;
    case 8: g = pg8::Gemm{(const bf16_t*)(P.ws + WS_OV), (const bf16_t*)(P.ws + WS_W2) + (size_t)l * D * DFF, M, D, DFF};
            E.mode = 2; E.perm = false; E.rs = pg8::EpiRes{P.out, P.out + (size_t)M_CTX * D, P.out, mod_vec(P, l, 0) + 5120, INP(I_B2) + (size_t)l * D}; is_gemm = true; break;
    }
    if (is_gemm) { pg8::StaticOrder S; S.init(M, g.N, G, b); pg8::gemm_phase<pg8::EpiAny, pg8::StaticOrder, true, true>(LDSP(lds), g, S, E); }
}

#ifndef CPU_EMU
namespace cg = cooperative_groups;
#define LAS __attribute__((address_space(3)))
#define XB_TMO      128
#define XB_XCNT(j)  (256  + 64 * (j))
#define XB_XSUB(j)  (1280 + 64 * (j))
#define XB_XGEN(j)  (2304 + 64 * (j))
#define XB_TOP      3328
#define XB_TOPGEN   3392
#define XCD_BAR_WORDS 3456
#define XB_SPIN_CAP (1u << 22)
__device__ __forceinline__ unsigned xb_ld(unsigned* p)              { return __hip_atomic_load(p, __ATOMIC_RELAXED, __HIP_MEMORY_SCOPE_AGENT); }
__device__ __forceinline__ unsigned xb_add(unsigned* p, unsigned v) { return __hip_atomic_fetch_add(p, v, __ATOMIC_RELAXED, __HIP_MEMORY_SCOPE_AGENT); }
__device__ __forceinline__ unsigned xb_xcc_id() { return (unsigned)__builtin_amdgcn_s_getreg((3 << 11) | 20) & 0xFu; }
#define XB_SPIN(cond, bar) do { unsigned _sp = 0; while (cond) { __builtin_amdgcn_s_sleep(1); \
    if ((++_sp & 255u) == 0u) { if (xb_ld(&(bar)[XB_TMO])) break; if (_sp > XB_SPIN_CAP) { atomicAdd(&(bar)[XB_TMO], 1u); break; } } } } while (0)
struct XcdBarrier { unsigned* bar; unsigned x; volatile LAS unsigned* st; };
__device__ __forceinline__ XcdBarrier xcd_barrier_post(unsigned* bar, volatile LAS unsigned* st) {
    XcdBarrier b; b.bar = bar; b.x = xb_xcc_id(); b.st = st;
    if (threadIdx.x == 0) (void)xb_add(&bar[XB_XCNT(b.x)], 1u);
    return b;
}
__device__ __forceinline__ void xcd_barrier_complete(unsigned* bar, unsigned x, unsigned& nloc, unsigned& nx) {
    const unsigned G = gridDim.x * gridDim.y * gridDim.z;
    unsigned sum, cnt, mine, sp = 0u;
    for (;;) {
        sum = 0u; cnt = 0u; mine = 0u;
#pragma unroll
        for (unsigned j = 0; j < 16; ++j) { const unsigned c = xb_ld(&bar[XB_XCNT(j)]); sum += c; cnt += (c > 0u) ? 1u : 0u; mine = (j == x) ? c : mine; }
        if (sum == G) break;
        __builtin_amdgcn_s_sleep(1);
        if ((++sp & 255u) == 0u) { if (xb_ld(&bar[XB_TMO])) break; if (sp > XB_SPIN_CAP) { atomicAdd(&bar[XB_TMO], 1u); break; } }
    }
    nloc = mine > 0u ? mine : 1u; nx = cnt > 0u ? cnt : 1u;
}
__device__ __forceinline__ void xcd_barrier(const XcdBarrier& b) {
    asm volatile("s_waitcnt vmcnt(0)" ::: "memory");
    __syncthreads();
    if (threadIdx.x == 0) {
        unsigned* bar = b.bar;
        __builtin_amdgcn_s_waitcnt(0);
        unsigned nloc = b.st[0], nx = b.st[1];
        if (nloc == 0u) { xcd_barrier_complete(bar, b.x, nloc, nx); b.st[0] = nloc; b.st[1] = nx; }
        const unsigned old = xb_add(&bar[XB_XSUB(b.x)], 1u);
        const unsigned gen = old / nloc;
        if (old + 1u == (gen + 1u) * nloc) {
            __builtin_amdgcn_fence(__ATOMIC_RELEASE, "agent");
            asm volatile("s_waitcnt vmcnt(0)" ::: "memory");
            const unsigned og = xb_add(&bar[XB_TOP], 1u);
            const unsigned tg = og / nx;
            if (og + 1u == (tg + 1u) * nx) xb_add(&bar[XB_TOPGEN], 1u);
            else XB_SPIN(xb_ld(&bar[XB_TOPGEN]) == tg, bar);
            __builtin_amdgcn_fence(__ATOMIC_ACQUIRE, "agent");
            xb_add(&bar[XB_XGEN(b.x)], 1u);
            asm volatile("s_waitcnt vmcnt(0)" ::: "memory");
        } else {
            XB_SPIN(xb_ld(&bar[XB_XGEN(b.x)]) == gen, bar);
            __builtin_amdgcn_fence(__ATOMIC_ACQUIRE, "agent");
            asm volatile("s_waitcnt vmcnt(0)" ::: "memory");
        }
    }
    __syncthreads();
}

constexpr int MISC_OFF = 131072 + 320;
constexpr size_t CTL_ZERO = 65536;
__global__ void __launch_bounds__(512, 2) mega_fwd(Params P, int ph_lo, int ph_hi) {
    extern __shared__ __attribute__((aligned(16))) unsigned char lds[];
    cg::grid_group grid = cg::this_grid();
    volatile LAS unsigned* misc = (volatile LAS unsigned*)((LAS unsigned char*)lds + MISC_OFF);
    if (threadIdx.x < 32) misc[threadIdx.x] = 0u;
    __syncthreads();
    XcdBarrier bar = xcd_barrier_post((unsigned*)(P.ws + WS_CTL) + 1024, misc + 8);
    for (int ph = ph_lo; ph < ph_hi; ++ph) {
        run_phase(P, ph, lds);
#ifdef PROBE_DOUBLE
        if (ph > 0 && ph < NPHASES - 1 && ((ph - 1) % PH_PER_LAYER) == PROBE_DOUBLE) { xcd_barrier(bar); run_phase(P, ph, lds); }
#endif
        if (ph + 1 < ph_hi) { if (P.ws == nullptr) grid.sync(); else xcd_barrier(bar); }
    }
}

extern "C" void kernel_launch(void* const* d_in, const int* in_sizes, int n_in, void* d_out, int out_size, void* d_ws, size_t ws_size, hipStream_t stream) {
    static int grid = 0;
    if (grid == 0) {
        if (n_in != N_IN || ws_size < WS_END) { fprintf(stderr, "kernel_launch: unexpected n_in %d or ws_size %zu (need %zu)\n", n_in, ws_size, (size_t)WS_END); grid = -1; return; }
        int dev = 0, cus = 0, per_cu = 0;
        (void)hipGetDevice(&dev); (void)hipDeviceGetAttribute(&cus, hipDeviceAttributeMultiprocessorCount, dev);
        (void)hipFuncSetAttribute((const void*)mega_fwd, hipFuncAttributeMaxDynamicSharedMemorySize, LDS_BYTES);
        (void)hipOccupancyMaxActiveBlocksPerMultiprocessor(&per_cu, (const void*)mega_fwd, 512, LDS_BYTES);
        if (per_cu < 1) { fprintf(stderr, "kernel_launch: occupancy query says %d blocks per CU\n", per_cu); per_cu = 1; }
        grid = cus * 1;
    }
    if (grid < 0) return;
    (void)hipMemsetAsync((char*)d_ws + WS_CTL, 0, CTL_ZERO, stream);
    Params p{};
    for (int i = 0; i < N_IN; ++i) p.in[i] = (const float*)d_in[i];
    p.out = (float*)d_out; p.ws = (unsigned char*)d_ws;
    int lo = 0, hi = NPHASES;
    void* args[] = {&p, &lo, &hi};
    hipError_t e = hipLaunchCooperativeKernel((const void*)mega_fwd, dim3(grid), dim3(512), args, LDS_BYTES, stream);
    if (e != hipSuccess) fprintf(stderr, "cooperative launch failed: %s (grid %d)\n", hipGetErrorString(e), grid);
}
#endif
```

```cpp
#ifndef CPU_EMU
#include <hip/hip_runtime.h>
#include <hip/hip_cooperative_groups.h>
#endif
#include <cstdio>
#include <cstdint>
#include <cmath>

#define DEV __device__ __forceinline__
#if defined(PROBE_TS) && !defined(CPU_EMU)
#define TS_START(id, lds_) do { if (PROBE_TS == (id) && threadIdx.x == 0) ((volatile unsigned*)((lds_) + 131072 + 320))[18] = (unsigned)__builtin_amdgcn_s_memrealtime(); } while (0)
#define TS_STOP(id, lds_) do { if (PROBE_TS == (id) && threadIdx.x == 0) { volatile unsigned* m_ = (volatile unsigned*)((lds_) + 131072 + 320); m_[17] = m_[17] + ((unsigned)__builtin_amdgcn_s_memrealtime() - m_[18]); } } while (0)
#else
#define TS_START(id, lds_)
#define TS_STOP(id, lds_)
#endif

#ifndef CFG_BATCH
#define CFG_BATCH 32
#define CFG_SEQ 256
#define CFG_DEC_BATCH 2
#define CFG_DEC_SEQ 4096
#define CFG_DEPTH 4
#endif
constexpr int D = 1024, BATCH = CFG_BATCH, SEQ = CFG_SEQ, DEC_BATCH = CFG_DEC_BATCH, DEC_SEQ = CFG_DEC_SEQ, DEPTH = CFG_DEPTH;
constexpr int M_CTX = BATCH * SEQ, M_LAT = DEC_BATCH * DEC_SEQ, M = M_CTX + M_LAT;
constexpr int NMOD = 1 + DEC_BATCH;
constexpr int D_IN = 2832, ZW = 3072, DFF = 4096, DG = 256;
constexpr int GRID_W = 64, GRID_ROWS = DEC_SEQ / GRID_W;
constexpr int ZB = 1024, ZC = 1280, ZD = 1792;
constexpr int ZD_V = ZD + 512, ZD_I = ZD + 768, ZD_F = ZD + 776, ZD_O = ZD + 784;
static_assert(M_CTX % 256 == 0 && M_LAT % 256 == 0 && SEQ % 64 == 0 && DEC_SEQ % 64 == 0, "shape");

enum { I_XP = 0, I_XS, I_C, I_SRWKV, I_SC, I_SN, I_SM, I_CCTX, I_WMOD, I_BMOD, I_N1G, I_N2G, I_WIN, I_WOUT,
       I_MU, I_W0, I_WUP, I_A0, I_AUP, I_GUP, I_KK, I_KA, I_RK, I_LNG, I_LNB, I_POOLW, I_POOLS, I_CDW, I_CB, I_CLNG, I_CLNB, I_CPW,
       I_QKCONV, I_IB, I_FB, I_HNG, I_W1, I_B1, I_W2, I_B2, I_FG, N_IN };

typedef unsigned short bf16_t;
typedef _Float16 f16;
constexpr size_t MiB = 1u << 20;
constexpr size_t WS_CTL = 0, CTL_BYTES = 1 * MiB;
constexpr size_t WS_MOD = 65536;
static_assert(WS_MOD + (size_t)DEPTH * NMOD * 6144 * 4 <= CTL_BYTES, "mod");
constexpr size_t WS_WIN = CTL_BYTES;
constexpr size_t WS_WOUT = WS_WIN + (size_t)DEPTH * ZW * D * 2;
constexpr size_t WS_W1 = WS_WOUT + (size_t)DEPTH * D * D * 2;
constexpr size_t WS_W2 = WS_W1 + (size_t)DEPTH * DFF * D * 2;
constexpr size_t WS_H = WS_W2 + (size_t)DEPTH * D * DFF * 2;
constexpr size_t WS_OV = WS_H + (size_t)M * D * 2;
constexpr size_t WS_Z = WS_OV;
constexpr int RCH_REC = 10496;
constexpr size_t WS_RCH = WS_Z + (size_t)M * ZW * 2;
constexpr size_t WS_RV = WS_RCH + (size_t)8 * (M / 16) * RCH_REC;
constexpr size_t WS_RG = WS_RV + (size_t)M * DG * 2;
constexpr size_t WS_RY = WS_RG + (size_t)M * DG * 2;
constexpr int NTC = M / 64;
constexpr size_t WS_UP = WS_RY + (size_t)2 * M * DG * 2;
constexpr size_t WS_CP = WS_UP + (size_t)2 * NTC * 4 * 4096 * 2;
constexpr size_t WS_NU = WS_CP + (size_t)2 * NTC * 4 * 4096 * 2;
constexpr size_t WS_NP = WS_NU + (size_t)2 * NTC * 4 * 64 * 4;
constexpr size_t WS_AB = WS_NP + (size_t)2 * NTC * 4 * 64 * 4;
constexpr size_t WS_MP = WS_AB + (size_t)2 * NTC * 4 * 2 * 4;
constexpr size_t WS_SW = WS_MP + (size_t)2 * NTC * 4 * 4;
constexpr int SW_WUP = 0, SW_AUP = 32768, SW_GUP = 65536, SW_CPW = 98304, SW_POOL = 163840, SW_LAYER = 180224;
constexpr size_t WS_END_A = WS_SW + (size_t)DEPTH * SW_LAYER * 2;
constexpr size_t WS_END_B = WS_OV + (size_t)M * DFF * 2;
constexpr size_t WS_END = WS_END_A > WS_END_B ? WS_END_A : WS_END_B;
#if CFG_BATCH == 32 && CFG_DEC_SEQ == 4096
static_assert(WS_END <= (size_t)384 * MiB, "workspace must fit 4x the largest tensor (384 MiB)");
#endif

constexpr int LDS_BYTES = 147456;

struct Params { const float* in[N_IN]; float* out; unsigned char* ws; };
#ifdef CPU_EMU
#define INP(i) (P.in[i])
#else
__device__ __forceinline__ const float* inp_(const Params& P, int i) { asm volatile("" : "+s"(i)); return P.in[i]; }
#define INP(i) inp_(P, (i))
#endif
#ifdef CPU_EMU
#define TID() ((int)threadIdx.x)
#else
__device__ __forceinline__ int tid_() { int t = threadIdx.x; asm volatile("" : "+v"(t)); return t; }
#define TID() tid_()
#endif

DEV float bf2f(bf16_t h) { unsigned u = (unsigned)h << 16; return __builtin_bit_cast(float, u); }
DEV bf16_t f2bf(float f) { unsigned u = __builtin_bit_cast(unsigned, f); return (bf16_t)((u + 0x7fffu + ((u >> 16) & 1u)) >> 16); }
DEV unsigned pk2(float lo, float hi) { return (unsigned)f2bf(lo) | ((unsigned)f2bf(hi) << 16); }
#ifdef CPU_EMU
DEV float fexp(float x) { return expf(x); }
DEV float flog(float x) { return logf(x); }
DEV float frcp(float x) { return 1.f / x; }
DEV float frsq(float x) { return 1.f / sqrtf(x); }
#else
DEV float fexp(float x) { return __builtin_amdgcn_exp2f(x * 1.44269504088896341f); }
DEV float flog(float x) { return __builtin_amdgcn_logf(x) * 0.69314718055994531f; }
DEV float frcp(float x) { return __builtin_amdgcn_rcpf(x); }
DEV float frsq(float x) { return __builtin_amdgcn_rsqf(x); }
#endif
DEV float sigm(float x) { return frcp(1.f + fexp(-x)); }
DEV float silu_(float x) { return x * sigm(x); }
DEV float softplus_(float x) { return fmaxf(x, 0.f) + flog(1.f + fexp(-fabsf(x))); }
DEV float tanh_(float x) { return 1.f - 2.f * frcp(1.f + fexp(2.f * x)); }
#ifdef CPU_EMU
DEV float dpp_xor1(float v) { return __shfl_xor(v, 1); }
DEV float dpp_xor2(float v) { return __shfl_xor(v, 2); }
DEV float dpp_hmir(float v) { const int l = threadIdx.x & 63; return __shfl(v, (l & ~7) | (7 - (l & 7))); }
DEV float dpp_mir(float v) { const int l = threadIdx.x & 63; return __shfl(v, (l & ~15) | (15 - (l & 15))); }
DEV float lane_get(float v, int src) { return __shfl(v, src); }
#else
template <int CTRL> DEV float dpp_(float v) { return __builtin_bit_cast(float, __builtin_amdgcn_update_dpp(0, __builtin_bit_cast(int, v), CTRL, 0xF, 0xF, true)); }
DEV float dpp_xor1(float v) { return dpp_<0xB1>(v); }
DEV float dpp_xor2(float v) { return dpp_<0x4E>(v); }
DEV float dpp_hmir(float v) { return dpp_<0x141>(v); }
DEV float dpp_mir(float v) { return dpp_<0x140>(v); }
DEV float lane_get(float v, int src) { return __builtin_bit_cast(float, __builtin_amdgcn_readlane(__builtin_bit_cast(int, v), src)); }
#endif
#ifdef CPU_EMU
DEV float lane_up(float v, int delta) { const int l = threadIdx.x & 63; return __shfl(v, l >= delta ? l - delta : l); }
#else
DEV float lane_up(float v, int delta) { return __shfl_up(v, delta); }
#endif
DEV float wave_incl_sum(float x, int lane) {
#pragma unroll
    for (int o = 1; o < 64; o <<= 1) { const float y = lane_up(x, o); if (lane >= o) x += y; }
    return x;
}
DEV float wave_incl_max(float x, int lane) {
#pragma unroll
    for (int o = 1; o < 64; o <<= 1) { const float y = lane_up(x, o); if (lane >= o) x = fmaxf(x, y); }
    return x;
}
DEV float sum16(float v) {
    v += dpp_xor1(v); v += dpp_xor2(v); v += dpp_hmir(v); v += dpp_mir(v); return v;
}
DEV float wave_sum(float v) {
    v = sum16(v);
    return (lane_get(v, 0) + lane_get(v, 16)) + (lane_get(v, 32) + lane_get(v, 48));
}
struct SeqInfo { int base, T, t, lat, sidx; };
DEV SeqInfo seq_of(int m) {
    SeqInfo s;
    if (m < M_CTX) { s.lat = 0; s.sidx = m / SEQ; s.T = SEQ; s.base = s.sidx * SEQ; s.t = m - s.base; }
    else { const int mm = m - M_CTX; s.lat = 1; s.sidx = mm / DEC_SEQ; s.T = DEC_SEQ; s.base = M_CTX + s.sidx * DEC_SEQ; s.t = mm - s.sidx * DEC_SEQ; }
    return s;
}
DEV int mod_index(int m) { return m < M_CTX ? 0 : 1 + (m - M_CTX) / DEC_SEQ; }
DEV const float* mod_vec(const Params& P, int l, int j) { return (const float*)(P.ws + WS_MOD) + ((size_t)l * NMOD + j) * 6144; }
DEV const float* xrow(const Params& P, bool from_input, int m) {
    if (from_input) return m < M_CTX ? INP(I_XP) + (size_t)m * D : INP(I_XS) + (size_t)(m - M_CTX) * D;
    return P.out + (size_t)m * D;
}

namespace pg8 {
typedef short bf16x8 __attribute__((ext_vector_type(8)));
typedef float f32x4 __attribute__((ext_vector_type(4)));
typedef unsigned u32x4 __attribute__((ext_vector_type(4)));
constexpr int BM = 256, BK = 64, HALF = 128, HTB = HALF * BK * 2, STAGE_BYTES = 8 * HTB, NXCD = 8, WGM = 4;
struct Unit { int pm, pn; };
struct Gemm { const bf16_t* A; const bf16_t* Bt; int M, N, K; };
struct StaticOrder {
    int nM, nN, nwg, G, c;
    __host__ __device__ void init(int M_, int N_, int G_, int c_) { nM = M_ / BM; nN = N_ / BM; nwg = nM * nN; G = G_; c = c_; }
    __host__ __device__ bool next(int i, Unit& u) const {
        const long L = (long)i * G + c; if (L >= nwg) return false;
        int wgid = (int)L; { const int q = nwg / NXCD, r = nwg % NXCD, xcd = wgid % NXCD, off = wgid / NXCD; wgid = (xcd < r ? xcd * (q + 1) : r * (q + 1) + (xcd - r) * q) + off; }
        const int nig = WGM * nN, gid = wgid / nig, fm = gid * WGM, gsz = (nM - fm) < WGM ? (nM - fm) : WGM;
        u.pm = fm + ((wgid % nig) % gsz); u.pn = (wgid % nig) / gsz; return true;
    }
    __device__ __forceinline__ void a_ready(const Unit&) const {}
    __device__ __forceinline__ void done(const Unit&) const {}
};

#ifdef CPU_EMU
#define PG8_LAS
DEV unsigned cvt_pk_bf16(float lo, float hi) { return pk2(lo, hi); }
template <class Epi, class Sched, bool ALIGN_EPI = false, bool SP2 = false>
DEV void gemm_phase(unsigned char* lds, const Gemm g, const Sched& S, const Epi& E) {
    const int tid = TID(), wid = tid >> 6, lane = tid & 63, wr = wid >> 2, wc = wid & 3, fr = lane & 15, fq = lane >> 4;
    Unit cur;
    for (int ui = 0; S.next(ui, cur); ++ui) {
        f32x4 acc[2][2][4][2];
        for (int ai = 0; ai < 2; ++ai) for (int bj = 0; bj < 2; ++bj) for (int m = 0; m < 4; ++m) for (int n = 0; n < 2; ++n) for (int j = 0; j < 4; ++j) {
            const int row = cur.pm * BM + ai * HALF + wr * 64 + m * 16 + fr;
            const int col = cur.pn * BM + bj * HALF + wc * 32 + (E.perm ? 8 * fq + 4 * n + j : 16 * n + 4 * fq + j);
            const bf16_t* a = g.A + (size_t)row * g.K; const bf16_t* b = g.Bt + (size_t)col * g.K;
            float s = 0.f; for (int k = 0; k < g.K; ++k) s += bf2f(a[k]) * bf2f(b[k]);
            acc[ai][bj][m][n][j] = s;
        }
        E(acc, cur, wr, wc, fr, fq);
    }
}
#else
#define PG8_LAS __attribute__((address_space(3)))
__host__ __device__ __forceinline__ int lds_byte(int r, int c) { const int st = (r >> 4) * 2 + (c >> 5), rr = r & 15, cc = c & 31, ob = rr * 64 + cc * 2; return st * 1024 + (ob ^ (((ob >> 9) & 1) << 5)); }
__host__ __device__ __forceinline__ void stage_rc(int b, int& R, int& C) { const int st = b / 1024, sb = b % 1024, swz = sb ^ (((sb >> 9) & 1) << 5); R = (st >> 1) * 16 + swz / 64; C = (st & 1) * 32 + (swz % 64) / 2; }
__host__ __device__ __forceinline__ int perm32(int rho) { const int n = rho >> 4, i = rho & 15; return 8 * (i >> 2) + 4 * n + (i & 3); }
__device__ __forceinline__ unsigned cvt_pk_bf16(float lo, float hi) { unsigned r; asm volatile("v_cvt_pk_bf16_f32 %0, %1, %2" : "=v"(r) : "v"(lo), "v"(hi)); return r; }

template <class Epi, class Sched, bool ALIGN_EPI = false, bool SP2 = false>
__device__ __forceinline__ void gemm_phase(PG8_LAS unsigned char* lds, const Gemm g, const Sched& S, const Epi& E) {
    const int tid = TID(), wid = __builtin_amdgcn_readfirstlane(tid >> 6), lane = tid & 63, wr = wid >> 2, wc = wid & 3, fr = lane & 15, fq = lane >> 4;
    const int K = g.K, nt = K / BK;
    unsigned voffA[2], voffB[2];
#pragma unroll
    for (int i = 0; i < 2; ++i) { int R, C; stage_rc(tid * 16 + i * 8192, R, C); const int Rb = E.perm ? ((R & ~31) + perm32(R & 31)) : R;
        voffA[i] = (unsigned)(R * K + C) * 2u; voffB[i] = (unsigned)(Rb * K + C) * 2u; }
    const size_t kstep = (size_t)(BK * 2);
    const size_t hstep = (size_t)HALF * K * 2;
    const size_t tstep = 2 * hstep;
    const unsigned ldsw = (unsigned)wid * 1024u;
    const int aoff = lds_byte(wr * 64 + fr, fq * 8), boff = lds_byte(wc * 32 + fr, fq * 8);
#define PG8_SA(b, h) (((b) * 2 + (h)) * HTB)
#define PG8_SB(b, h) ((4 + (b) * 2 + (h)) * HTB)
#define PG8_STAGE(bufoff, gbase, voff) do { _Pragma("unroll") for (int _i = 0; _i < 2; ++_i) \
        __builtin_amdgcn_global_load_lds((const unsigned*)((const char*)(gbase) + (voff)[_i]), (PG8_LAS unsigned*)(lds + (bufoff) + ldsw + _i * 8192), 16, 0, 0); } while (0)
#define PG8_LDA(dst, b, h) do { _Pragma("unroll") for (int m = 0; m < 4; ++m) _Pragma("unroll") for (int k = 0; k < 2; ++k) dst[m][k] = *(const PG8_LAS bf16x8*)(lds + PG8_SA(b, h) + aoff + m * 2048 + k * 1024); } while (0)
#define PG8_LDB(dst, b, h) do { _Pragma("unroll") for (int n = 0; n < 2; ++n) _Pragma("unroll") for (int k = 0; k < 2; ++k) dst[n][k] = *(const PG8_LAS bf16x8*)(lds + PG8_SB(b, h) + boff + n * 2048 + k * 1024); } while (0)
#define PG8_MMA(ai, bj, At, Bt) do { __builtin_amdgcn_s_setprio(1); _Pragma("unroll") for (int m = 0; m < 4; ++m) _Pragma("unroll") for (int n = 0; n < 2; ++n) _Pragma("unroll") for (int k = 0; k < 2; ++k) \
        acc[ai][bj][m][n] = __builtin_amdgcn_mfma_f32_16x16x32_bf16(Bt[n][k], At[m][k], acc[ai][bj][m][n], 0, 0, 0); __builtin_amdgcn_s_setprio(0); } while (0)
#define PG8_WAIT_V(n) asm volatile("s_waitcnt vmcnt(" #n ")" ::: "memory")
#define PG8_WAIT_L(n) asm volatile("s_waitcnt lgkmcnt(" #n ")" ::: "memory")
#define PG8_BAR __builtin_amdgcn_s_barrier()
#define PG8_SCHED __builtin_amdgcn_sched_barrier(0)
    Unit cur, nxt; int ui = 0;
    if (!S.next(0, cur)) return;
    f32x4 acc[2][2][4][2];
#pragma unroll
    for (int a = 0; a < 2; ++a)
#pragma unroll
        for (int b = 0; b < 2; ++b)
#pragma unroll
            for (int m = 0; m < 4; ++m)
#pragma unroll
                for (int n = 0; n < 2; ++n) acc[a][b][m][n] = (f32x4){0.f, 0.f, 0.f, 0.f};
    bf16x8 At[4][2], B0[2][2], B1[2][2];
    const char* cA = (const char*)g.A + (size_t)cur.pm * tstep; const char* cB = (const char*)g.Bt + (size_t)cur.pn * tstep;
    S.a_ready(cur);
    if constexpr (SP2) {
        PG8_STAGE(PG8_SB(0, 0), cB, voffB); PG8_STAGE(PG8_SB(0, 1), cB + hstep, voffB); PG8_STAGE(PG8_SA(0, 0), cA, voffA); PG8_STAGE(PG8_SA(0, 1), cA + hstep, voffA);
        if (wr == 1) PG8_BAR;
        PG8_WAIT_V(2); PG8_BAR;
        PG8_STAGE(PG8_SB(1, 0), cB + kstep, voffB); PG8_STAGE(PG8_SA(1, 0), cA + kstep, voffA); PG8_STAGE(PG8_SB(1, 1), cB + hstep + kstep, voffB);
        PG8_WAIT_V(6); PG8_BAR;
    } else {
        PG8_STAGE(PG8_SB(0, 0), cB, voffB); PG8_STAGE(PG8_SA(0, 0), cA, voffA); PG8_STAGE(PG8_SB(0, 1), cB + hstep, voffB); PG8_STAGE(PG8_SA(0, 1), cA + hstep, voffA);
        if (wr == 1) PG8_BAR;
        PG8_WAIT_V(4); PG8_BAR;
        PG8_STAGE(PG8_SB(1, 0), cB + kstep, voffB); PG8_STAGE(PG8_SA(1, 0), cA + kstep, voffA); PG8_STAGE(PG8_SB(1, 1), cB + hstep + kstep, voffB);
        PG8_WAIT_V(6); PG8_BAR;
    }
    for (;;) {
        const bool has_next = S.next(ui + 1, nxt);
        const char* nA = has_next ? (const char*)g.A + (size_t)nxt.pm * tstep : cA; const char* nB = has_next ? (const char*)g.Bt + (size_t)nxt.pn * tstep : cB;
        for (int t = 0; t < nt; t += 2) {
            const bool last = (t == nt - 2);
            const char* a1 = cA + (size_t)(t + 1) * kstep;
            const char* a2 = last ? nA : cA + (size_t)(t + 2) * kstep; const char* b2 = last ? nB : cB + (size_t)(t + 2) * kstep;
            const char* a3 = a2 + kstep; const char* b3 = b2 + kstep;
            if (last && has_next) S.a_ready(nxt);
            if constexpr (SP2) {
            PG8_LDB(B0, 0, 0); PG8_LDB(B1, 0, 1); PG8_SCHED; PG8_LDA(At, 0, 0); PG8_STAGE(PG8_SA(1, 1), a1 + hstep, voffA);
            PG8_WAIT_V(8); PG8_WAIT_L(0); PG8_BAR; PG8_MMA(0, 0, At, B0); PG8_MMA(0, 1, At, B1); PG8_BAR; PG8_SCHED;
            PG8_LDA(At, 0, 1); PG8_STAGE(PG8_SB(0, 0), b2, voffB); PG8_STAGE(PG8_SB(0, 1), b2 + hstep, voffB); PG8_STAGE(PG8_SA(0, 0), a2, voffA);
            PG8_WAIT_V(8); PG8_WAIT_L(0); PG8_BAR; PG8_MMA(1, 0, At, B0); PG8_MMA(1, 1, At, B1); PG8_BAR; PG8_SCHED;
            PG8_LDB(B0, 1, 0); PG8_LDB(B1, 1, 1); PG8_SCHED; PG8_LDA(At, 1, 0); PG8_STAGE(PG8_SA(0, 1), a2 + hstep, voffA);
            PG8_WAIT_V(8); PG8_WAIT_L(0); PG8_BAR; PG8_MMA(0, 0, At, B0); PG8_MMA(0, 1, At, B1); PG8_BAR; PG8_SCHED;
            PG8_LDA(At, 1, 1); PG8_STAGE(PG8_SB(1, 0), b3, voffB); PG8_STAGE(PG8_SB(1, 1), b3 + hstep, voffB); PG8_STAGE(PG8_SA(1, 0), a3, voffA);
            PG8_WAIT_V(8); PG8_WAIT_L(0); PG8_BAR; PG8_MMA(1, 0, At, B0); PG8_MMA(1, 1, At, B1); PG8_BAR; PG8_SCHED;
            } else {
            PG8_LDB(B0, 0, 0); PG8_SCHED; PG8_LDA(At, 0, 0); PG8_STAGE(PG8_SA(1, 1), a1 + hstep, voffA);
            PG8_WAIT_L(8); PG8_BAR; PG8_WAIT_L(0); PG8_MMA(0, 0, At, B0); PG8_BAR; PG8_SCHED;
            PG8_LDB(B1, 0, 1); PG8_STAGE(PG8_SB(0, 0), b2, voffB);
            PG8_BAR; PG8_WAIT_L(0); PG8_MMA(0, 1, At, B1); PG8_BAR;
            PG8_LDA(At, 0, 1); PG8_STAGE(PG8_SA(0, 0), a2, voffA);
            PG8_BAR; PG8_WAIT_L(0); PG8_MMA(1, 0, At, B0); PG8_BAR; PG8_SCHED;
            PG8_STAGE(PG8_SB(0, 1), b2 + hstep, voffB);
            PG8_WAIT_V(6); PG8_BAR; PG8_MMA(1, 1, At, B1); PG8_BAR;
            PG8_LDB(B0, 1, 0); PG8_SCHED; PG8_LDA(At, 1, 0); PG8_STAGE(PG8_SA(0, 1), a2 + hstep, voffA);
            PG8_WAIT_L(8); PG8_BAR; PG8_WAIT_L(0); PG8_MMA(0, 0, At, B0); PG8_BAR; PG8_SCHED;
            PG8_LDB(B1, 1, 1); PG8_STAGE(PG8_SB(1, 0), b3, voffB);
            PG8_BAR; PG8_WAIT_L(0); PG8_MMA(0, 1, At, B1); PG8_BAR;
            PG8_LDA(At, 1, 1); PG8_STAGE(PG8_SA(1, 0), a3, voffA);
            PG8_BAR; PG8_WAIT_L(0); PG8_MMA(1, 0, At, B0); PG8_BAR; PG8_SCHED;
            PG8_STAGE(PG8_SB(1, 1), b3 + hstep, voffB);
            PG8_WAIT_V(6); PG8_BAR; PG8_MMA(1, 1, At, B1); PG8_BAR;
            }
        }
        if constexpr (ALIGN_EPI) { if (wr == 0) PG8_BAR; }
        E(acc, cur, wr, wc, fr, fq); S.done(cur);
        if (!has_next) break;
#pragma unroll
        for (int a = 0; a < 2; ++a)
#pragma unroll
            for (int b = 0; b < 2; ++b)
#pragma unroll
                for (int m = 0; m < 4; ++m)
#pragma unroll
                    for (int n = 0; n < 2; ++n) acc[a][b][m][n] = (f32x4){0.f, 0.f, 0.f, 0.f};
        cur = nxt; cA = nA; cB = nB; ++ui;
        if constexpr (ALIGN_EPI) { if (wr == 1) PG8_BAR; }
    }
    PG8_WAIT_V(0);
    if constexpr (!ALIGN_EPI) { if (wr == 0) PG8_BAR; }
    PG8_BAR;
#undef PG8_SA
#undef PG8_SB
#undef PG8_STAGE
#undef PG8_LDA
#undef PG8_LDB
#undef PG8_MMA
#undef PG8_WAIT_V
#undef PG8_WAIT_L
#undef PG8_BAR
#undef PG8_SCHED
}
#endif

template <int ACT  > struct EpiBf16 {
    static constexpr bool PERM = true, AFTER_DRAIN = false;
    bf16_t* O; int ldc; const float* bias;
    DEV void operator()(const f32x4 (&acc)[2][2][4][2], const Unit& u, int wr, int wc, int fr, int fq) const {
        const int row0 = u.pm * BM + wr * 64 + fr, col0 = u.pn * BM + wc * 32 + 8 * fq;
        f32x4 bv[2][2];
#pragma unroll
        for (int bj = 0; bj < 2; ++bj)
#pragma unroll
            for (int n = 0; n < 2; ++n) bv[bj][n] = bias ? *(const f32x4*)(bias + col0 + bj * HALF + 4 * n) : (f32x4){0.f, 0.f, 0.f, 0.f};
#pragma unroll
        for (int ai = 0; ai < 2; ++ai)
#pragma unroll
            for (int m = 0; m < 4; ++m) { bf16_t* rowp = O + (size_t)(row0 + ai * HALF + m * 16) * ldc + col0;
#pragma unroll
                for (int bj = 0; bj < 2; ++bj) { f32x4 v0 = acc[ai][bj][m][0] + bv[bj][0], v1 = acc[ai][bj][m][1] + bv[bj][1];
                    if (ACT == 1) {
#pragma unroll
                        for (int j = 0; j < 4; ++j) { const float a = fmaxf(v0[j], 0.f), b = fmaxf(v1[j], 0.f); v0[j] = a * a; v1[j] = b * b; } }
                    u32x4 w; w.x = cvt_pk_bf16(v0[0], v0[1]); w.y = cvt_pk_bf16(v0[2], v0[3]); w.z = cvt_pk_bf16(v1[0], v1[1]); w.w = cvt_pk_bf16(v1[2], v1[3]);
                    *(u32x4*)(rowp + bj * HALF) = w; } }
    }
};
struct EpiRes {
    static constexpr bool PERM = false, AFTER_DRAIN = false;
    const float* base_ctx; const float* base_lat; float* out; const float* gate; const float* bias;
    DEV void operator()(const f32x4 (&acc)[2][2][4][2], const Unit& u, int wr, int wc, int fr, int fq) const {
        const int col0 = u.pn * BM + wc * 32 + 4 * fq;
#pragma unroll
        for (int ai = 0; ai < 2; ++ai)
#pragma unroll
            for (int m = 0; m < 4; ++m) { const int r = u.pm * BM + ai * HALF + wr * 64 + m * 16 + fr;
                const float* bs = r < M_CTX ? base_ctx + (size_t)r * D : base_lat + (size_t)(r - M_CTX) * D;
                const float* gt = gate + (size_t)mod_index(r) * 6144; float* orow = out + (size_t)r * D;
#pragma unroll
                for (int bj = 0; bj < 2; ++bj)
#pragma unroll
                    for (int n = 0; n < 2; ++n) { const int c = col0 + bj * HALF + n * 16;
                        f32x4 v = acc[ai][bj][m][n]; if (bias) v = v + *(const f32x4*)(bias + c);
                        const f32x4 o = *(const f32x4*)(bs + c) + *(const f32x4*)(gt + c) * v; *(f32x4*)(orow + c) = o; } }
    }
};
struct EpiAny {
    static constexpr bool AFTER_DRAIN = false;
    int mode; bool perm; EpiBf16<0> b0; EpiBf16<1> b1; EpiRes rs;
    DEV void operator()(const f32x4 (&acc)[2][2][4][2], const Unit& u, int wr, int wc, int fr, int fq) const {
        if (mode == 0) b0(acc, u, wr, wc, fr, fq); else if (mode == 1) b1(acc, u, wr, wc, fr, fq); else rs(acc, u, wr, wc, fr, fq);
    }
};
}

#ifdef CPU_EMU
#define LDSP(p) (p)
#else
#define LDSP(p) ((PG8_LAS unsigned char*)(p))
#endif

constexpr int LT = 72;
#ifdef CPU_EMU
DEV pg8::f32x4 mfma16(pg8::bf16x8 a, pg8::bf16x8 b, pg8::f32x4 c) { return emu::mfma16(a, b, c); }
#else
DEV pg8::f32x4 mfma16(pg8::bf16x8 a, pg8::bf16x8 b, pg8::f32x4 c) { return __builtin_amdgcn_mfma_f32_16x16x32_bf16(a, b, c, 0, 0, 0); }
#endif
typedef f16 h4 __attribute__((ext_vector_type(4)));
#ifdef CPU_EMU
DEV pg8::f32x4 mfma16h(h4 a, h4 b, pg8::f32x4 c) { return emu::mfma16h(a, b, c); }
#else
DEV pg8::f32x4 mfma16h(h4 a, h4 b, pg8::f32x4 c) { return __builtin_amdgcn_mfma_f32_16x16x16f16(a, b, c, 0, 0, 0); }
#endif
DEV h4 cvt_h4(pg8::f32x4 v) { return (h4){(f16)v[0], (f16)v[1], (f16)v[2], (f16)v[3]}; }
DEV pg8::f32x4 tile_mm64(const bf16_t* A, int r0, const bf16_t* Bt, int c0, int fr, int fq) {
    pg8::f32x4 acc = {0.f, 0.f, 0.f, 0.f};
#pragma unroll
    for (int ks = 0; ks < 2; ++ks) { const pg8::bf16x8 a = *(const pg8::bf16x8*)(A + (r0 + fr) * LT + ks * 32 + fq * 8), b = *(const pg8::bf16x8*)(Bt + (c0 + fr) * LT + ks * 32 + fq * 8); acc = mfma16(a, b, acc); }
    return acc;
}

DEV void transpose_item(const float* W, int K, int N, int Npad, bf16_t* WT, int item, float* s  ) {
    const int tid = TID(), nblk = Npad / 256, kb = item / nblk, nb = item % nblk, k0 = kb * 64, n0 = nb * 256;
    {
        const int n = tid & 255, kp = tid >> 8; const bool ok = n0 + n < N; const float* wp = W + (size_t)(k0 + kp) * N + n0 + (ok ? n : 0);
        float tv[32];
#pragma unroll
        for (int i = 0; i < 32; ++i) tv[i] = wp[(size_t)(2 * i) * N];
#pragma unroll
        for (int i = 0; i < 32; ++i) s[(2 * i + kp) * 257 + n] = ok ? tv[i] : 0.f;
    }
    __syncthreads();
#pragma unroll
    for (int j = 0; j < 4; ++j) {
        const int q = tid + 512 * j, c = q & 7, n = q >> 3;
        const float* sp = s + (8 * c) * 257 + n;
        pg8::u32x4 o; o.x = pk2(sp[0], sp[257]); o.y = pk2(sp[2 * 257], sp[3 * 257]); o.z = pk2(sp[4 * 257], sp[5 * 257]); o.w = pk2(sp[6 * 257], sp[7 * 257]);
        *(pg8::u32x4*)(WT + (size_t)(n0 + n) * K + k0 + 8 * c) = o;
    }
    __syncthreads();
}
DEV void phase_prologue(const Params& P, unsigned char* lds) {
    const int tid = TID();
    float* s = (float*)lds;
    constexpr int I_IN = 16 * (ZW / 256), I_OUT = 16 * 4, I_1 = 16 * 16, I_2 = 64 * 4, I_L = I_IN + I_OUT + I_1 + I_2;
    for (int it = blockIdx.x; it < DEPTH * I_L; it += gridDim.x) {
        const int l = it / I_L; int r = it % I_L;
        if (r < I_IN) { transpose_item(INP(I_WIN) + (size_t)l * D * D_IN, D, D_IN, ZW, (bf16_t*)(P.ws + WS_WIN) + (size_t)l * ZW * D, r, s); continue; } r -= I_IN;
        if (r < I_OUT) { transpose_item(INP(I_WOUT) + (size_t)l * D * D, D, D, D, (bf16_t*)(P.ws + WS_WOUT) + (size_t)l * D * D, r, s); continue; } r -= I_OUT;
        if (r < I_1) { transpose_item(INP(I_W1) + (size_t)l * D * DFF, D, DFF, DFF, (bf16_t*)(P.ws + WS_W1) + (size_t)l * DFF * D, r, s); continue; } r -= I_1;
        transpose_item(INP(I_W2) + (size_t)l * DFF * D, DFF, D, D, (bf16_t*)(P.ws + WS_W2) + (size_t)l * D * DFF, r, s);
    }
    for (int e = blockIdx.x * 512 + tid; e < DEPTH * SW_LAYER; e += gridDim.x * 512) {
        const int l = e / SW_LAYER, q = e % SW_LAYER; float v;
        if (q < SW_AUP) { const int d = q >> 14, c = (q >> 6) & 255, j = q & 63; v = INP(I_WUP)[(((size_t)l * 2 + d) * 64 + j) * DG + c]; }
        else if (q < SW_GUP) { const int q2 = q - SW_AUP, d = q2 >> 14, c = (q2 >> 6) & 255, j = q2 & 63; v = INP(I_AUP)[(((size_t)l * 2 + d) * 64 + j) * DG + c]; }
        else if (q < SW_CPW) { const int q2 = q - SW_GUP, c = q2 >> 7, j = q2 & 127; v = INP(I_GUP)[((size_t)l * 128 + j) * DG + c]; }
        else if (q < SW_POOL) { const int q2 = q - SW_CPW, co = q2 >> 8, ci = q2 & 255; v = INP(I_CPW)[((size_t)l * DG + ci) * DG + co]; }
        else { const int q2 = q - SW_POOL, gi = q2 >> 12, o = (q2 >> 6) & 63, ci = q2 & 63; v = INP(I_POOLW)[(((size_t)l * 4 + gi) * 64 + ci) * 64 + o]; }
        ((bf16_t*)(P.ws + WS_SW))[e] = f2bf(v);
    }
    for (int it = blockIdx.x; it < DEPTH * 96; it += gridDim.x) {
        const int l = it / 96, n0 = (it % 96) * 64, n = tid & 63, kg = tid >> 6;
        __syncthreads();
        for (int e = tid; e < NMOD * 1024; e += 512) { const int j = e >> 10, k = e & 1023; const float cv = (j == 0) ? INP(I_CCTX)[k] : INP(I_C)[(size_t)(j - 1) * D + k]; s[e] = silu_(cv); }
        __syncthreads();
        const float* w = INP(I_WMOD) + ((size_t)l * D + kg * 128) * 6144 + n0 + n;
        float a[NMOD];
#pragma unroll
        for (int j = 0; j < NMOD; ++j) a[j] = 0.f;
#pragma unroll
        for (int kb = 0; kb < 4; ++kb) { float wv[32];
#pragma unroll
            for (int k = 0; k < 32; ++k) wv[k] = w[(size_t)(kb * 32 + k) * 6144];
#pragma unroll
            for (int k = 0; k < 32; ++k)
#pragma unroll
                for (int j = 0; j < NMOD; ++j) a[j] += s[j * 1024 + kg * 128 + kb * 32 + k] * wv[k]; }
        float* part = s + NMOD * 1024;
#pragma unroll
        for (int j = 0; j < NMOD; ++j) part[(kg * NMOD + j) * 64 + n] = a[j];
        __syncthreads();
        if (tid < NMOD * 64) { const int j = tid >> 6, nn = tid & 63; float t = INP(I_BMOD)[(size_t)l * 6144 + n0 + nn];
#pragma unroll
            for (int g = 0; g < 8; ++g) t += part[(g * NMOD + j) * 64 + nn];
            ((float*)(P.ws + WS_MOD))[((size_t)l * NMOD + j) * 6144 + n0 + nn] = t; }
    }
}

DEV void phase_norm(const Params& P, int l, int which  ) {
    const int tid = TID(), lane = tid & 63, wave = tid >> 6;
    const int gw = blockIdx.x * 8 + wave, NGW = gridDim.x * 8;
    const float* ng = INP(which ? I_N2G : I_N1G) + (size_t)l * D;
    const bool from_input = (l == 0 && which == 0);
    bf16_t* H = (bf16_t*)(P.ws + WS_H);
    for (int m0 = gw; m0 < M; m0 += 2 * NGW) {
        const int mm[2] = {m0, m0 + NGW < M ? m0 + NGW : m0};
        pg8::f32x4 v[2][4]; float ss[2] = {0.f, 0.f};
#pragma unroll
        for (int q = 0; q < 2; ++q) { const float* xr = xrow(P, from_input, mm[q]);
#pragma unroll
            for (int j = 0; j < 4; ++j) v[q][j] = *(const pg8::f32x4*)(xr + 4 * lane + 256 * j); }
#pragma unroll
        for (int q = 0; q < 2; ++q) {
#pragma unroll
            for (int j = 0; j < 4; ++j) ss[q] += (v[q][j][0] * v[q][j][0] + v[q][j][1] * v[q][j][1]) + (v[q][j][2] * v[q][j][2] + v[q][j][3] * v[q][j][3]);
            const float rs = frsq(wave_sum(ss[q]) * (1.f / D) + 1e-6f);
            const float* mv = mod_vec(P, l, mod_index(mm[q])) + which * 3072;
#pragma unroll
            for (int j = 0; j < 4; ++j) { const int c = 4 * lane + 256 * j;
                const pg8::f32x4 g = *(const pg8::f32x4*)(ng + c), sh = *(const pg8::f32x4*)(mv + c), sc = *(const pg8::f32x4*)(mv + 1024 + c);
                const pg8::f32x4 o = v[q][j] * rs * g * (sc + 1.f) + sh;
                unsigned long long w = (unsigned long long)pk2(o[0], o[1]) | ((unsigned long long)pk2(o[2], o[3]) << 32);
                *(unsigned long long*)(H + (size_t)mm[q] * D + c) = w; } }
    }
}
DEV void phase_final(const Params& P) {
    const int tid = TID(), lane = tid & 63, wave = tid >> 6;
    const int gw = blockIdx.x * 8 + wave, NGW = gridDim.x * 8;
    const float* ng = INP(I_FG);
    for (int m = gw; m < M; m += NGW) {
        float* xr = P.out + (size_t)m * D;
        pg8::f32x4 v[4]; float ss = 0.f;
#pragma unroll
        for (int j = 0; j < 4; ++j) { v[j] = *(const pg8::f32x4*)(xr + 4 * lane + 256 * j); ss += (v[j][0] * v[j][0] + v[j][1] * v[j][1]) + (v[j][2] * v[j][2] + v[j][3] * v[j][3]); }
        const float rs = frsq(wave_sum(ss) * (1.f / D) + 1e-6f);
#pragma unroll
        for (int j = 0; j < 4; ++j) { const int c = 4 * lane + 256 * j; *(pg8::f32x4*)(xr + c) = v[j] * rs * *(const pg8::f32x4*)(ng + c); }
    }
}

constexpr int ZS_LD = 1024 + 8;
DEV float zmix(const bf16_t* Zs, int row, int col, float mu) {
    const float z0 = bf2f(Zs[row * ZS_LD + col]); return z0 + (0.5f * (bf2f(Zs[(row - 1) * ZS_LD + col]) + bf2f(Zs[(row + 1) * ZS_LD + col])) - z0) * mu;
}
DEV void rwkv_prep_item(const Params& P, int l, int it, unsigned char* lds) {
    const int tid = TID(), lane = tid & 63, wave = tid >> 6, fr = lane & 15, fq = lane >> 4;
    const bf16_t* Z = (const bf16_t*)(P.ws + WS_Z);
    bf16_t* Zs = (bf16_t*)lds; bf16_t* LRw = (bf16_t*)(lds + 111616); bf16_t* LRa = LRw + 32 * 72; bf16_t* LRg = LRa + 32 * 72; float* inv = (float*)(LRg + 32 * 136);
    const bf16_t* SW = (const bf16_t*)(P.ws + WS_SW) + (size_t)l * SW_LAYER;
    const int m0 = it * 32; const SeqInfo s0 = seq_of(m0);
    __syncthreads();
#pragma unroll
    for (int r = 0; r < 9; ++r) { const int e = tid + 512 * r, row = e >> 7, ch = e & 127, t = s0.t - 1 + row, tc = t < 0 ? 0 : (t >= s0.T ? s0.T - 1 : t);
        if (e < 34 * 128) { pg8::u32x4 v = *(const pg8::u32x4*)(Z + (size_t)(s0.base + tc) * ZW + ch * 8); if (t != tc) v = (pg8::u32x4){0u, 0u, 0u, 0u};
            *(pg8::u32x4*)(Zs + row * ZS_LD + ch * 8) = v; } }
    __syncthreads();
    {
        const int c = tid & 255, tg = tid >> 8; const float* mu = INP(I_MU) + (size_t)l * 1024; const float mu_k = mu[256 + c], mu_l = mu[768 + c], k_k = INP(I_KK)[(size_t)l * DG + c];
#pragma unroll 4
        for (int tt = 0; tt < 16; ++tt) { const int tl = tg * 16 + tt;
            const float lo = zmix(Zs, tl + 1, 768 + c, mu_l);
            if (c < 64) LRw[tl * 72 + c] = f2bf(tanh_(lo)); else if (c < 128) LRa[tl * 72 + c - 64] = f2bf(lo); else LRg[tl * 136 + c - 128] = f2bf(sigm(lo));
            const float kk = zmix(Zs, tl + 1, 256 + c, mu_k) * k_k, ssq = wave_sum(kk * kk);
            if (lane == 0) inv[tl * 4 + (c >> 6)] = frsq(ssq + 1e-12f); }
    }
    __syncthreads();
    const int h = wave & 3, rt = wave >> 2;
    float rv[4][4], kv[4][4], kkv[4][4];
    {
        pg8::f32x4 ag[4];
#pragma unroll
        for (int ct = 0; ct < 4; ++ct) { ag[ct] = (pg8::f32x4){0.f, 0.f, 0.f, 0.f};
#pragma unroll
            for (int ks = 0; ks < 4; ++ks) ag[ct] = mfma16(*(const pg8::bf16x8*)(LRg + (16 * rt + fr) * 136 + ks * 32 + fq * 8), *(const pg8::bf16x8*)(SW + SW_GUP + (64 * h + 16 * ct + fr) * 128 + ks * 32 + fq * 8), ag[ct]); }
        const float* mu = INP(I_MU) + (size_t)l * 1024;
#pragma unroll
        for (int ct = 0; ct < 4; ++ct) { const int c = 64 * h + 16 * ct + fr; const float mu_r = mu[c], mu_k = mu[256 + c], mu_v = mu[512 + c], k_k = INP(I_KK)[(size_t)l * DG + c];
#pragma unroll
            for (int i = 0; i < 4; ++i) { const int tl = 16 * rt + 4 * fq + i; const size_t o = (size_t)(m0 + tl) * DG + c;
                const float r = zmix(Zs, tl + 1, c, mu_r), k = zmix(Zs, tl + 1, 256 + c, mu_k), v = zmix(Zs, tl + 1, 512 + c, mu_v), kk = k * k_k * inv[tl * 4 + h];
                rv[ct][i] = r; kv[ct][i] = k; kkv[ct][i] = kk;
                ((f16*)(P.ws + WS_RV))[o] = (f16)v; ((f16*)(P.ws + WS_RG))[o] = (f16)ag[ct][i]; } }
    }
    __syncthreads();
    {
        unsigned char* wl = lds + wave * 13952;
        f16* XA = (f16*)wl; f16* XR = XA + 16 * 68; f16* XB = XR + 16 * 68; f16* XK = XB + 16 * 68;
        float* Ew = (float*)(XK + 16 * 68); float* LAs = Ew + 16 * 64; float* bonW = LAs + 16 * 17;
        const int mc = m0 + 16 * rt;
        float kav[4], rkv[4];
        { const float* kap = INP(I_KA) + (size_t)l * DG + 64 * h + fr; const float* rkp = INP(I_RK) + (size_t)l * DG + 64 * h + fr;
#pragma unroll
          for (int ct = 0; ct < 4; ++ct) { kav[ct] = kap[16 * ct]; rkv[ct] = rkp[16 * ct]; } }
#pragma unroll 1
        for (int d = 0; d < 2; ++d) {
            unsigned char* rec = P.ws + WS_RCH + ((size_t)(d * 4 + h) * (M / 16) + mc / 16) * RCH_REC;
            float ev[4][4], kdv[4][4], bv[4][4], bp[4] = {0.f, 0.f, 0.f, 0.f};
            float w0v[4], a0v[4]; pg8::bf16x8 bw[4][2], ba[4][2];
            { const float* w0p = INP(I_W0) + ((size_t)l * 2 + d) * DG + 64 * h + fr; const float* a0p = INP(I_A0) + ((size_t)l * 2 + d) * DG + 64 * h + fr;
#pragma unroll
              for (int ct = 0; ct < 4; ++ct) { w0v[ct] = w0p[16 * ct]; a0v[ct] = a0p[16 * ct];
#pragma unroll
                  for (int ks = 0; ks < 2; ++ks) { const int bo = ((d * 256 + 64 * h + 16 * ct + fr) * 64) + ks * 32 + fq * 8; bw[ct][ks] = *(const pg8::bf16x8*)(SW + SW_WUP + bo); ba[ct][ks] = *(const pg8::bf16x8*)(SW + SW_AUP + bo); } } }
#pragma unroll
            for (int ct = 0; ct < 4; ++ct) {
                pg8::f32x4 aw = {0.f, 0.f, 0.f, 0.f}, aa = {0.f, 0.f, 0.f, 0.f};
#pragma unroll
                for (int ks = 0; ks < 2; ++ks) {
                    aw = mfma16(*(const pg8::bf16x8*)(LRw + (16 * rt + fr) * 72 + ks * 32 + fq * 8), bw[ct][ks], aw);
                    aa = mfma16(*(const pg8::bf16x8*)(LRa + (16 * rt + fr) * 72 + ks * 32 + fq * 8), ba[ct][ks], aa); }
                const float w0 = w0v[ct], a0 = a0v[ct], k_a = kav[ct], r_k = rkv[ct];
#pragma unroll
                for (int i = 0; i < 4; ++i) { const float e = fexp(-softplus_(-(w0 + aw[i])) - 0.5f), a = sigm(a0 + aa[i]);
                    ev[ct][i] = e; kdv[ct][i] = kv[ct][i] * (1.f + (a - 1.f) * k_a); bv[ct][i] = kkv[ct][i] * a; bp[i] += rv[ct][i] * kdv[ct][i] * r_k;
                    Ew[(4 * fq + i) * 64 + 16 * ct + fr] = e; } }
#pragma unroll
            for (int i = 0; i < 4; ++i) { const float bs = sum16(bp[i]); const int tok = 4 * fq + i; if (fr == 0) bonW[d ? 15 - tok : tok] = bs; }
            __syncthreads();
            {
                float cum = 0.f;
#pragma unroll
                for (int pos = 0; pos < 16; ++pos) { const int tok = d ? 15 - pos : pos; const float x = Ew[tok * 64 + lane]; Ew[tok * 64 + lane] = cum; cum += x; }
                ((float*)(rec + 10240))[lane] = fexp(-cum);
            }
            __syncthreads();
#pragma unroll
            for (int ct = 0; ct < 4; ++ct)
#pragma unroll
                for (int i = 0; i < 4; ++i) { const int tok = 4 * fq + i, k = 16 * ct + fr, pos = d ? 15 - tok : tok; const float cb = Ew[tok * 64 + k], e = ev[ct][i];
                    const float wm1 = fexp(-cb), iw = fexp(cb + e), wt = fexp(-(cb + e));
                    const f16 al = (f16)(kkv[ct][i] * wm1), rh = (f16)(rv[ct][i] * wt), be = (f16)(bv[ct][i] * iw), ka = (f16)(kdv[ct][i] * iw);
                    XA[pos * 68 + k] = al; XR[pos * 68 + k] = rh; XB[pos * 68 + k] = be; XK[pos * 68 + k] = ka;
                    { const int o = pos * 64 + ((((k >> 3) ^ (pos >> 1)) & 7) << 3) + (k & 7); ((f16*)rec)[o] = al; ((f16*)(rec + 2048))[o] = rh; } }
            __syncthreads();
            {
                typedef f16 h8v __attribute__((ext_vector_type(8)));
                h8v b0, b1, k0, k1;
#pragma unroll
                for (int sx = 0; sx < 8; ++sx) { b0[sx] = XB[sx * 68 + lane]; b1[sx] = XB[(8 + sx) * 68 + lane]; k0[sx] = XK[sx * 68 + lane]; k1[sx] = XK[(8 + sx) * 68 + lane]; }
                { const int sw = ((lane >> 3) & 1) * 16; *(h8v*)(rec + 4096 + lane * 32 + sw) = b0; *(h8v*)(rec + 4096 + lane * 32 + (sw ^ 16)) = b1; *(h8v*)(rec + 6144 + lane * 32 + sw) = k0; *(h8v*)(rec + 6144 + lane * 32 + (sw ^ 16)) = k1; }
            }
            {
                pg8::f32x4 la = {0.f, 0.f, 0.f, 0.f}, lb = la, ma = la, mb = la;
#pragma unroll
                for (int j = 0; j < 4; ++j) { const h4 xa = *(const h4*)(XA + fr * 68 + 16 * j + 4 * fq), xr = *(const h4*)(XR + fr * 68 + 16 * j + 4 * fq), xb = *(const h4*)(XB + fr * 68 + 16 * j + 4 * fq), xk = *(const h4*)(XK + fr * 68 + 16 * j + 4 * fq);
                    la = mfma16h(xa, xb, la); lb = mfma16h(xa, xk, lb); ma = mfma16h(xr, xb, ma); mb = mfma16h(xr, xk, mb); }
#pragma unroll
                for (int i = 0; i < 4; ++i) { const int t = 4 * fq + i, sx = fr;
                    LAs[t * 17 + sx] = sx < t ? la[i] : 0.f;
                    const int mo = t * 16 + ((((sx >> 3) ^ (t >> 3)) & 1) << 3) + (sx & 7);
                    ((f16*)(rec + 8192))[mo] = (f16)(sx < t ? lb[i] : 0.f);
                    ((f16*)(rec + 9216))[mo] = (f16)(sx <= t ? ma[i] : 0.f);
                    ((f16*)(rec + 9728))[mo] = (f16)((sx <= t ? mb[i] : 0.f) + (sx == t ? bonW[t] : 0.f)); }
            }
            __syncthreads();
            {
                const int col = lane & 15; float tc[16];
#pragma unroll
                for (int t = 0; t < 16; ++t) { float x = (t == col) ? 1.f : 0.f;
#pragma unroll
                    for (int sx = 0; sx < t; ++sx) x -= LAs[t * 17 + sx] * tc[sx];
                    tc[t] = x; }
                if (lane < 16) {
#pragma unroll
                    for (int t = 0; t < 16; ++t) ((f16*)(rec + 8704))[t * 16 + ((((col >> 3) ^ (t >> 3)) & 1) << 3) + (col & 7)] = (f16)(-tc[t]); }
            }
            __syncthreads();
        }
    }
}
DEV void phase_rwkv_prep(const Params& P, int l, unsigned char* lds) { for (int it = blockIdx.x; it < M / 32; it += gridDim.x) rwkv_prep_item(P, l, it, lds); }

constexpr int CS_STAGE = 4 * RCH_REC + 4 * 2048;
struct CsEarly { h4 al[4], rh[4], lb, vop; };
struct CsLate { h4 bt[4], kt[4], nt, ma, mb; pg8::f32x4 wc[4]; };
DEV CsEarly cs_load_early(const unsigned char* im, const unsigned char* vim, int fr, int fq, int vcol2, int d) {
    CsEarly o; const int h8 = 8 * (fq & 1), mx = (((fq >> 1) ^ (fr >> 3)) & 1) << 4;
#pragma unroll
    for (int j = 0; j < 4; ++j) { const int go = fr * 128 + ((((2 * j + (fq >> 1)) ^ (fr >> 1)) & 7) << 4) + h8; o.al[j] = *(const h4*)(im + go); o.rh[j] = *(const h4*)(im + 2048 + go); }
    o.lb = *(const h4*)(im + 8192 + fr * 32 + mx + h8);
#pragma unroll
    for (int jj = 0; jj < 4; ++jj) { const int sx = 4 * fq + jj, tok = d ? 15 - sx : sx; o.vop[jj] = *(const f16*)(vim + tok * 128 + vcol2); }
    return o;
}
DEV CsLate cs_load_late(const unsigned char* im, int fr, int fq) {
    CsLate o; const int h8 = 8 * (fq & 1), mx = (((fq >> 1) ^ (fr >> 3)) & 1) << 4;
#pragma unroll
    for (int j = 0; j < 4; ++j) { o.bt[j] = *(const h4*)(im + 4096 + (16 * j + fr) * 32 + mx + h8); o.kt[j] = *(const h4*)(im + 6144 + (16 * j + fr) * 32 + mx + h8); o.wc[j] = *(const pg8::f32x4*)(im + 10240 + (16 * j + 4 * fq) * 4); }
    o.nt = *(const h4*)(im + 8704 + fr * 32 + mx + h8); o.ma = *(const h4*)(im + 9216 + fr * 32 + mx + h8); o.mb = *(const h4*)(im + 9728 + fr * 32 + mx + h8);
    return o;
}
#ifdef CPU_EMU
#define SCHED_FENCE()
#define WAVE_UNIFORM(x) (x)
#else
#define SCHED_FENCE() __builtin_amdgcn_sched_barrier(0)
#define WAVE_UNIFORM(x) __builtin_amdgcn_readfirstlane(x)
#endif
DEV void rwkv_chunk_scan_item(const Params& P, int l, int chain, unsigned char* lds) {
    const int tid = TID(), lane = tid & 63, wave = WAVE_UNIFORM(tid >> 6), fr = lane & 15, fq = lane >> 4;
    const int d = chain & 1, h = (chain >> 1) & 3, sq = chain >> 3;
    const bool lat = sq >= BATCH;
    const int T = lat ? DEC_SEQ : SEQ, base = lat ? M_CTX + (sq - BATCH) * DEC_SEQ : sq * SEQ;
    const unsigned char* RCH = P.ws + WS_RCH + (size_t)(d * 4 + h) * (M / 16) * RCH_REC;
    const unsigned char* RVb = P.ws + WS_RV + (size_t)h * 128;
    f16* RY = (f16*)(P.ws + WS_RY) + (size_t)d * M * DG;
    const bool scanner = wave < 4; const int vs = 16 * wave;
    pg8::f32x4 S[4];
    if (scanner && lat) { const float* si = INP(I_SRWKV) + ((((size_t)(sq - BATCH) * DEPTH + l) * 2 + d) * 4 + h) * 4096 + (size_t)(vs + fr) * 64 + 4 * fq;
#pragma unroll
        for (int j = 0; j < 4; ++j) S[j] = *(const pg8::f32x4*)(si + 16 * j); }
    else {
#pragma unroll
        for (int j = 0; j < 4; ++j) S[j] = (pg8::f32x4){0.f, 0.f, 0.f, 0.f}; }
    const int lt = tid - 256;
    pg8::u32x4 gA[13], gB[13];
#define CS_GLOAD(G_, st) do { const int c0_ = d ? (T / 16 - 4 - 4 * (st)) : 4 * (st); const unsigned char* rs_ = RCH + (size_t)(base / 16 + c0_) * RCH_REC + lt * 16; \
        _Pragma("unroll") for (int r_ = 0; r_ < 11; ++r_) if (r_ < 10 || lt < 64) G_[r_] = *(const pg8::u32x4*)(rs_ + r_ * 4096); \
        const unsigned char* vs_ = RVb + (size_t)(base + 16 * c0_ + (lt >> 3)) * 512 + (lt & 7) * 16; \
        G_[11] = *(const pg8::u32x4*)vs_; G_[12] = *(const pg8::u32x4*)(vs_ + 32 * 512); } while (0)
#define CS_LSTORE(G_, bb) do { unsigned char* ld_ = lds + (bb) * CS_STAGE + lt * 16; \
        _Pragma("unroll") for (int r_ = 0; r_ < 11; ++r_) if (r_ < 10 || lt < 64) *(pg8::u32x4*)(ld_ + r_ * 4096) = G_[r_]; \
        *(pg8::u32x4*)(ld_ + 4 * RCH_REC) = G_[11]; *(pg8::u32x4*)(ld_ + 4 * RCH_REC + 4096) = G_[12]; } while (0)
#define CS_COMPUTE(st) do { { const unsigned char* im0 = lds + ((st) & 1) * CS_STAGE; \
            const unsigned char* vm0 = im0 + 4 * RCH_REC; \
            CsEarly cur = cs_load_early(im0 + (d ? 3 : 0) * RCH_REC, vm0 + (d ? 3 : 0) * 2048, fr, fq, (vs + fr) * 2, d); \
            _Pragma("unroll") for (int q = 0; q < 4; ++q) { \
                const CsLate lt_ = cs_load_late(im0 + (d ? 3 - q : q) * RCH_REC, fr, fq); \
                CsEarly nxt = cur; if (q < 3) nxt = cs_load_early(im0 + (d ? 2 - q : q + 1) * RCH_REC, vm0 + (d ? 2 - q : q + 1) * 2048, fr, fq, (vs + fr) * 2, d); \
                SCHED_FENCE(); \
                const int ck = d ? (T / 16 - 1 - (4 * (st) + q)) : 4 * (st) + q; \
                h4 s16[4]; \
                _Pragma("unroll") for (int j = 0; j < 4; ++j) s16[j] = cvt_h4(S[j]); \
                pg8::f32x4 dd = {0.f, 0.f, 0.f, 0.f}, yy = {0.f, 0.f, 0.f, 0.f}; \
                _Pragma("unroll") for (int j = 0; j < 4; ++j) dd = mfma16h(cur.al[j], s16[j], dd); \
                dd = mfma16h(cur.lb, cur.vop, dd); \
                _Pragma("unroll") for (int j = 0; j < 4; ++j) yy = mfma16h(cur.rh[j], s16[j], yy); \
                yy = mfma16h(lt_.mb, cur.vop, yy); \
                const h4 e16 = cvt_h4(dd); \
                const pg8::f32x4 pp = mfma16h(lt_.nt, e16, (pg8::f32x4){0.f, 0.f, 0.f, 0.f}); \
                _Pragma("unroll") for (int j = 0; j < 4; ++j) S[j] = mfma16h(lt_.kt[j], cur.vop, S[j]); \
                const h4 p16 = cvt_h4(pp); \
                _Pragma("unroll") for (int j = 0; j < 4; ++j) S[j] = mfma16h(lt_.bt[j], p16, S[j]); \
                yy = mfma16h(lt_.ma, p16, yy); \
                _Pragma("unroll") for (int j = 0; j < 4; ++j) S[j] = S[j] * lt_.wc[j]; \
                f16* yp_ = RY + (size_t)(base + 16 * ck) * DG + h * 64 + vs + fr; \
                _Pragma("unroll") for (int i = 0; i < 4; ++i) { const int sx = 4 * fq + i, tok = d ? 15 - sx : sx; yp_[tok * DG] = (f16)yy[i]; } \
                cur = nxt; \
            } } } while (0)
    const int nst = T / 64;
    __syncthreads();
    if (!scanner) {
        CS_GLOAD(gA, 0); CS_LSTORE(gA, 0); if (nst > 1) CS_GLOAD(gB, 1); if (nst > 2) CS_GLOAD(gA, 2);
        __syncthreads();
        for (int st = 0; st < nst; st += 2) {
            if (st + 1 < nst) CS_LSTORE(gB, 1);
            if (st + 3 < nst) CS_GLOAD(gB, st + 3);
            __syncthreads();
            if (st + 1 >= nst) break;
            if (st + 2 < nst) CS_LSTORE(gA, 0);
            if (st + 4 < nst) CS_GLOAD(gA, st + 4);
            __syncthreads();
        }
    } else {
        __syncthreads();
        for (int st = 0; st < nst; ++st) { CS_COMPUTE(st); __syncthreads(); }
    }
#undef CS_GLOAD
#undef CS_LSTORE
#undef CS_COMPUTE
    if (!lat && scanner) { float* so = P.out + (size_t)M * D + ((((size_t)sq * DEPTH + l) * 2 + d) * 4 + h) * 4096 + (size_t)(vs + fr) * 64 + 4 * fq;
#pragma unroll
        for (int j = 0; j < 4; ++j) *(pg8::f32x4*)(so + 16 * j) = S[j]; }
}

DEV void unpack8(pg8::u32x4 v, float (&o)[8]) {
#pragma unroll
    for (int j = 0; j < 4; ++j) { o[2 * j] = __builtin_bit_cast(float, v[j] << 16); o[2 * j + 1] = __builtin_bit_cast(float, v[j] & 0xffff0000u); }
}
DEV void mlstm_load_kv(const Params& P, int l, const bf16_t* Z, const SeqInfo& s0, int h, bf16_t* Qs, bf16_t* Ks, bf16_t* KTs, bf16_t* VTs, int tid) {
    const float* cw = INP(I_QKCONV) + (size_t)l * 3 * 512;
    const int i = tid >> 3, c8 = (tid & 7) * 8, t = s0.t + i;
    pg8::u32x4 zq[3], zk[3]; float msk[3];
#pragma unroll
    for (int j = 0; j < 3; ++j) { const int tt = t + j - 1, tc = tt < 0 ? 0 : (tt >= s0.T ? s0.T - 1 : tt); msk[j] = (tt >= 0 && tt < s0.T) ? 1.f : 0.f;
        const bf16_t* zr = Z + ((size_t)s0.base + tc) * ZW + ZD + h * 64 + c8; if (Qs) zq[j] = *(const pg8::u32x4*)zr; zk[j] = *(const pg8::u32x4*)(zr + 256); }
    const pg8::u32x4 zv = *(const pg8::u32x4*)(Z + ((size_t)s0.base + t) * ZW + ZD_V + h * 64 + c8);
    float aq[8], ak[8];
#pragma unroll
    for (int e = 0; e < 8; ++e) { aq[e] = 0.f; ak[e] = 0.f; }
#pragma unroll
    for (int j = 0; j < 3; ++j) { float xq[8], xk[8]; if (Qs) unpack8(zq[j], xq); unpack8(zk[j], xk);
        const float* wq = cw + j * 512 + h * 64 + c8; const pg8::f32x4 wk0 = *(const pg8::f32x4*)(wq + 256), wk1 = *(const pg8::f32x4*)(wq + 260);
#pragma unroll
        for (int e = 0; e < 8; ++e) ak[e] += xk[e] * (e < 4 ? wk0[e] : wk1[e - 4]) * msk[j];
        if (Qs) { const pg8::f32x4 wq0 = *(const pg8::f32x4*)wq, wq1 = *(const pg8::f32x4*)(wq + 4);
#pragma unroll
            for (int e = 0; e < 8; ++e) aq[e] += xq[e] * (e < 4 ? wq0[e] : wq1[e - 4]) * msk[j]; } }
    pg8::u32x4 kb;
#pragma unroll
    for (int e = 0; e < 4; ++e) kb[e] = pk2(silu_(ak[2 * e]) * 0.125f, silu_(ak[2 * e + 1]) * 0.125f);
    if (Qs) { pg8::u32x4 qb;
#pragma unroll
        for (int e = 0; e < 4; ++e) qb[e] = pk2(silu_(aq[2 * e]), silu_(aq[2 * e + 1]));
        *(pg8::u32x4*)(Qs + i * LT + c8) = qb; *(pg8::u32x4*)(Ks + i * LT + c8) = kb; }
#pragma unroll
    for (int e = 0; e < 8; ++e) { const bf16_t kv = (bf16_t)(kb[e >> 1] >> (16 * (e & 1))), vv = (bf16_t)(zv[e >> 1] >> (16 * (e & 1)));
        if (KTs) KTs[(c8 + e) * LT + i] = kv;
        VTs[(c8 + e) * LT + i] = vv; }
}
DEV void mlstm_local_item(const Params& P, int l, int it, unsigned char* lds) {
    const int tid = TID(), lane = tid & 63, wave = tid >> 6, fr = lane & 15, fq = lane >> 4;
    const int tcg = it >> 2, h = it & 3, m0 = tcg * 64; const SeqInfo s0 = seq_of(m0);
    const bf16_t* Z = (const bf16_t*)(P.ws + WS_Z);
    bf16_t* KTs = (bf16_t*)lds; bf16_t* VTs = KTs + 64 * LT; bf16_t* VWs = VTs + 64 * LT;
    float* li = (float*)(VWs + 2 * 64 * LT); float* lf = li + 128; float* wend = lf + 128;
    __syncthreads();
    mlstm_load_kv(P, l, Z, s0, h, nullptr, nullptr, KTs, VTs, tid);
    if (tid < 128) { const int d = tid >> 6, i = tid & 63; const size_t m = (size_t)m0 + i;
        li[tid] = bf2f(Z[m * ZW + ZD_I + d * 4 + h]) + INP(I_IB)[(size_t)l * 8 + d * 4 + h]; lf[tid] = -softplus_(-(bf2f(Z[m * ZW + ZD_F + d * 4 + h]) + INP(I_FB)[(size_t)l * 8 + d * 4 + h])); }
    __syncthreads();
    if (wave < 2) { const int d = wave, tok = d ? 63 - lane : lane;
        const float b = wave_incl_sum(lf[d * 64 + tok], lane), a = li[d * 64 + tok] - b;
        const float amax = lane_get(wave_incl_max(a, lane), 63), btot = lane_get(b, 63);
        wend[d * 64 + tok] = fexp(a - amax);
        if (lane == 0) { float* ab = (float*)(P.ws + WS_AB) + (((size_t)d * NTC + tcg) * 4 + h) * 2; ab[0] = btot + amax; ab[1] = btot; } }
    __syncthreads();
#pragma unroll
    for (int r = 0; r < 16; ++r) { const int e = tid + 512 * r, d = e >> 12, v = (e >> 6) & 63, sx = e & 63; VWs[(d * 64 + v) * LT + sx] = f2bf(wend[d * 64 + sx] * bf2f(VTs[v * LT + sx])); }
    if (tid < 128) { const int d = tid >> 6, k = tid & 63; float a = 0.f; for (int sx = 0; sx < 64; ++sx) a += wend[d * 64 + sx] * bf2f(KTs[k * LT + sx]);
        ((float*)(P.ws + WS_NU))[(((size_t)d * NTC + tcg) * 4 + h) * 64 + k] = a; }
    __syncthreads();
    {
        const int d = wave >> 2, tr = wave & 3; f16* up = (f16*)(P.ws + WS_UP) + (((size_t)d * NTC + tcg) * 4 + h) * 4096;
#pragma unroll
        for (int tc = 0; tc < 4; ++tc) { const pg8::f32x4 acc = tile_mm64(VWs + d * 64 * LT, 16 * tr, KTs, 16 * tc, fr, fq);
#pragma unroll
            for (int i = 0; i < 4; ++i) up[(16 * tr + 4 * fq + i) * 64 + 16 * tc + fr] = (f16)acc[i]; }
    }
}
typedef f16 h8 __attribute__((ext_vector_type(8)));
DEV void mlstm_state_item(const Params& P, int l, int chain, unsigned char* lds) {
    const int tid = TID();
    const int d = chain & 1, h = (chain >> 1) & 3, sq = chain >> 3;
    const bool lat = sq >= BATCH;
    const int T = lat ? DEC_SEQ : SEQ, base = lat ? M_CTX + (sq - BATCH) * DEC_SEQ : sq * SEQ, nc = T / 64, tc0 = base / 64;
    float C[8], n = 0.f, m = 0.f;
    if (lat) { const size_t sb = ((((size_t)(sq - BATCH) * DEPTH + l) * 2 + d) * 4 + h); const float* c0 = INP(I_SC) + sb * 4096 + tid * 8;
#pragma unroll
        for (int j = 0; j < 8; ++j) C[j] = c0[j];
        if (tid < 64) n = INP(I_SN)[sb * 64 + tid];
        m = INP(I_SM)[sb]; }
    else {
#pragma unroll
        for (int j = 0; j < 8; ++j) C[j] = 0.f; }
    const f16* UP = (const f16*)(P.ws + WS_UP); f16* CP = (f16*)(P.ws + WS_CP);
    const float* NU = (const float*)(P.ws + WS_NU); float* NP = (float*)(P.ws + WS_NP); const float* AB = (const float*)(P.ws + WS_AB); float* MP = (float*)(P.ws + WS_MP);
    size_t ix = ((size_t)d * NTC + tc0 + (d ? nc - 1 : 0)) * 4 + h; const long dix = d ? -4 : 4;
    h8 u = *(const h8*)(UP + ix * 4096 + tid * 8); float nu = tid < 64 ? NU[ix * 64 + tid] : 0.f; float ac = AB[ix * 2], bc = AB[ix * 2 + 1];
    for (int ci = 0; ci < nc; ++ci) {
        const size_t cx = ix; const h8 uc = u; const float nuc = nu, acc_ = ac, bcc = bc;
        if (ci + 1 < nc) { ix += dix; u = *(const h8*)(UP + ix * 4096 + tid * 8); nu = tid < 64 ? NU[ix * 64 + tid] : 0.f; ac = AB[ix * 2]; bc = AB[ix * 2 + 1]; }
        h8 cp;
#pragma unroll
        for (int j = 0; j < 8; ++j) cp[j] = (f16)C[j];
        *(h8*)(CP + cx * 4096 + tid * 8) = cp;
        if (tid < 64) NP[cx * 64 + tid] = n;
        if (tid == 0) MP[cx] = m;
        const float mn = fmaxf(m + bcc, acc_), cd = fexp(m + bcc - mn), cu = fexp(acc_ - mn);
#pragma unroll
        for (int j = 0; j < 8; ++j) C[j] = cd * C[j] + cu * (float)uc[j];
        n = cd * n + cu * nuc; m = mn;
    }
    if (!lat) {
        const size_t sb = ((((size_t)sq * DEPTH + l) * 2 + d) * 4 + h);
        float* oc = P.out + (size_t)M * D + (size_t)BATCH * DEPTH * 8 * 4096 + sb * 4096 + tid * 8;
#pragma unroll
        for (int j = 0; j < 8; ++j) oc[j] = C[j];
        if (tid < 64) P.out[(size_t)M * D + (size_t)2 * BATCH * DEPTH * 8 * 4096 + sb * 64 + tid] = n;
        if (tid == 0) P.out[(size_t)M * D + (size_t)2 * BATCH * DEPTH * 8 * 4096 + (size_t)BATCH * DEPTH * 8 * 64 + sb] = m;
    }
}
DEV void mlstm_out_item(const Params& P, int l, int it, unsigned char* lds) {
    const int tid = TID(), lane = tid & 63, wave = tid >> 6, fr = lane & 15, fq = lane >> 4;
    const int tcg = it >> 2, h = it & 3, m0 = tcg * 64; const SeqInfo s0 = seq_of(m0);
    const bf16_t* Z = (const bf16_t*)(P.ws + WS_Z);
    bf16_t* Y = (bf16_t*)(P.ws + WS_H);
    bf16_t* Qs = (bf16_t*)lds; bf16_t* Ks = Qs + 64 * LT; bf16_t* VTs = Ks + 64 * LT; bf16_t* Ss = VTs + 64 * LT; bf16_t* Cs = Ss + 2 * 64 * LT;
    float* li = (float*)(Cs + 2 * 64 * LT); float* lf = li + 128; float* bc = lf + 128; float* ml = bc + 128; float* e1 = ml + 128; float* e2 = e1 + 128; float* fl = e2 + 128; float* np = fl + 128;
    float* mp = np + 128; float* Hs = mp + 4;
    __syncthreads();
    bf16_t opre_[4][4]; float hng_[4];
    { const int tr_ = wave & 3;
#pragma unroll
      for (int tc = 0; tc < 4; ++tc) { hng_[tc] = INP(I_HNG)[(size_t)l * DG + h * 64 + 16 * tc + fr];
#pragma unroll
          for (int i = 0; i < 4; ++i) opre_[tc][i] = Z[(size_t)(m0 + 16 * tr_ + 4 * fq + i) * ZW + ZD_O + h * 64 + 16 * tc + fr]; } }
    mlstm_load_kv(P, l, Z, s0, h, Qs, Ks, nullptr, VTs, tid);
    if (tid < 128) { const int d = tid >> 6, i = tid & 63; const size_t m = (size_t)m0 + i;
        li[tid] = bf2f(Z[m * ZW + ZD_I + d * 4 + h]) + INP(I_IB)[(size_t)l * 8 + d * 4 + h]; lf[tid] = -softplus_(-(bf2f(Z[m * ZW + ZD_F + d * 4 + h]) + INP(I_FB)[(size_t)l * 8 + d * 4 + h]));
        np[tid] = ((const float*)(P.ws + WS_NP))[(((size_t)d * NTC + tcg) * 4 + h) * 64 + i]; }
    if (tid < 2) mp[tid] = ((const float*)(P.ws + WS_MP))[((size_t)tid * NTC + tcg) * 4 + h];
#pragma unroll
    for (int r = 0; r < 2; ++r) { const int e = (tid + 512 * r) * 8, d = e >> 12, v = (e >> 6) & 63, k = e & 63;
        const h8 c = *(const h8*)((const f16*)(P.ws + WS_CP) + (((size_t)d * NTC + tcg) * 4 + h) * 4096 + (e & 4095));
        pg8::u32x4 w; w.x = pk2((float)c[0], (float)c[1]); w.y = pk2((float)c[2], (float)c[3]); w.z = pk2((float)c[4], (float)c[5]); w.w = pk2((float)c[6], (float)c[7]);
        *(pg8::u32x4*)(Cs + (d * 64 + v) * LT + k) = w; }
    __syncthreads();
    if (wave < 2) { const int d = wave, x = d * 64 + (d ? 63 - lane : lane); const float m_prev = mp[d];
        const float b = wave_incl_sum(lf[x], lane), run = wave_incl_max(li[x] - b, lane), mloc = b + run, mt = fmaxf(b + m_prev, mloc);
        bc[x] = b; ml[x] = mloc; e1[x] = fexp(mloc - mt); e2[x] = fexp(b + m_prev - mt); fl[x] = fexp(-mt); }
    __syncthreads();
    {
        const int tr = wave >> 1;
#pragma unroll
        for (int cc = 0; cc < 2; ++cc) { const int tc = 2 * (wave & 1) + cc; const pg8::f32x4 acc = tile_mm64(Qs, 16 * tr, Ks, 16 * tc, fr, fq); const int sx = 16 * tc + fr;
#pragma unroll
            for (int i = 0; i < 4; ++i) { const int t = 16 * tr + 4 * fq + i;
#pragma unroll
                for (int d = 0; d < 2; ++d) { const bool ok = d ? sx >= t : sx <= t; const float w = ok ? fexp(bc[d * 64 + t] - bc[d * 64 + sx] + li[d * 64 + sx] - ml[d * 64 + t]) : 0.f;
                    Ss[(d * 64 + t) * LT + sx] = f2bf(acc[i] * w); } } }
    }
    __syncthreads();
    const int d = wave >> 2, tr = wave & 3;
    float hreg[4][4];
    {
        float den[4], nq[4];
#pragma unroll
        for (int i = 0; i < 4; ++i) { const int t = 16 * tr + 4 * fq + i; float a = 0.f, b = 0.f;
#pragma unroll
            for (int j = 0; j < 4; ++j) { a += bf2f(Ss[(d * 64 + t) * LT + fr * 4 + j]); b += np[d * 64 + fr * 4 + j] * bf2f(Qs[t * LT + fr * 4 + j]); }
            den[i] = sum16(a); nq[i] = sum16(b); }
#pragma unroll
        for (int tc = 0; tc < 4; ++tc) { const pg8::f32x4 num = tile_mm64(Ss + d * 64 * LT, 16 * tr, VTs, 16 * tc, fr, fq), cq = tile_mm64(Qs, 16 * tr, Cs + d * 64 * LT, 16 * tc, fr, fq);
#pragma unroll
            for (int i = 0; i < 4; ++i) { const int x = d * 64 + 16 * tr + 4 * fq + i; const float dn = fmaxf(fabsf(e1[x] * den[i] + e2[x] * nq[i]), fl[x]);
                hreg[tc][i] = (e1[x] * num[i] + e2[x] * cq[i]) / dn; } }
    }
    if (d == 1) {
#pragma unroll
        for (int tc = 0; tc < 4; ++tc)
#pragma unroll
            for (int i = 0; i < 4; ++i) Hs[(16 * tr + 4 * fq + i) * 65 + 16 * tc + fr] = hreg[tc][i]; }
    __syncthreads();
    if (d == 0) {
        float ss[4] = {0.f, 0.f, 0.f, 0.f};
#pragma unroll
        for (int tc = 0; tc < 4; ++tc)
#pragma unroll
            for (int i = 0; i < 4; ++i) { const int t = 16 * tr + 4 * fq + i, v = 16 * tc + fr; const float op = bf2f(opre_[tc][i]);
                const float x = (hreg[tc][i] + Hs[t * 65 + v]) * sigm(op); hreg[tc][i] = x; ss[i] += x * x; }
#pragma unroll
        for (int i = 0; i < 4; ++i) ss[i] = frsq(sum16(ss[i]) * (1.f / 64.f) + 1e-6f);
#pragma unroll
        for (int tc = 0; tc < 4; ++tc) { const float g = hng_[tc];
#pragma unroll
            for (int i = 0; i < 4; ++i) Y[(size_t)(m0 + 16 * tr + 4 * fq + i) * D + 768 + h * 64 + 16 * tc + fr] = f2bf(hreg[tc][i] * ss[i] * g); }
    }
}

DEV void conv_item(const Params& P, int l, int it, unsigned char* lds) {
    const int tid = TID(), c = tid & 255, tg = tid >> 8, lane = tid & 63, wave = tid >> 6, fr = lane & 15, fq = lane >> 4;
    const bf16_t* Z = (const bf16_t*)(P.ws + WS_Z);
    bf16_t* Y = (bf16_t*)(P.ws + WS_H);
    float* u = (float*)lds;
    float* cv = u + 62 * 256;
    float* st = cv + 32 * 256;
    bf16_t* As = (bf16_t*)lds;
    const int m0 = it * 32; const SeqInfo s0 = seq_of(m0);
    __syncthreads();
    float dw[31];
#pragma unroll
    for (int j = 0; j < 31; ++j) dw[j] = INP(I_CDW)[((size_t)l * 31 + j) * DG + c];
    const float cb = INP(I_CB)[(size_t)l * DG + c], lg = INP(I_CLNG)[(size_t)l * DG + c], lb = INP(I_CLNB)[(size_t)l * DG + c];
    pg8::bf16x8 bop[8][2];
    { const bf16_t* BT = (const bf16_t*)(P.ws + WS_SW) + (size_t)l * SW_LAYER + SW_CPW;
#pragma unroll
      for (int ks = 0; ks < 8; ++ks)
#pragma unroll
          for (int cc = 0; cc < 2; ++cc) bop[ks][cc] = *(const pg8::bf16x8*)(BT + (size_t)(32 * wave + 16 * cc + fr) * 256 + ks * 32 + fq * 8); }
#pragma unroll
    for (int r = 0; r < 4; ++r) { const int e = tid + 512 * r, rr = e >> 5, c8 = (e & 31) * 8, t = s0.t - 15 + rr, tc = t < 0 ? 0 : (t >= s0.T ? s0.T - 1 : t);
        if (e >= 62 * 32) continue;
        pg8::f32x4 o0 = {0.f, 0.f, 0.f, 0.f}, o1 = {0.f, 0.f, 0.f, 0.f};
        const bf16_t* zr = Z + (size_t)(s0.base + tc) * ZW + ZC + c8; const pg8::u32x4 va = *(const pg8::u32x4*)zr, ga = *(const pg8::u32x4*)(zr + 256);
        if (t == tc) {
#pragma unroll
            for (int j = 0; j < 4; ++j) { const float v0 = __builtin_bit_cast(float, va[j] << 16), v1 = __builtin_bit_cast(float, va[j] & 0xffff0000u), g0 = __builtin_bit_cast(float, ga[j] << 16), g1 = __builtin_bit_cast(float, ga[j] & 0xffff0000u);
                const float a = v0 * sigm(g0), b = v1 * sigm(g1); if (j < 2) { o0[2 * j] = a; o0[2 * j + 1] = b; } else { o1[2 * j - 4] = a; o1[2 * j - 3] = b; } } }
        *(pg8::f32x4*)(u + rr * 256 + c8) = o0; *(pg8::f32x4*)(u + rr * 256 + c8 + 4) = o1; }
    __syncthreads();
    {
#pragma unroll 4
        for (int tt = 0; tt < 16; ++tt) { const int tl = tg * 16 + tt; float a = cb;
#pragma unroll
            for (int j = 0; j < 31; ++j) a += u[(tl + j) * 256 + c] * dw[j];
            cv[tl * 256 + c] = a; }
    }
    __syncthreads();
#pragma unroll
    for (int r = 0; r < 4; ++r) { const int tl = wave * 4 + r; float x[4]; float sm = 0.f;
#pragma unroll
        for (int j = 0; j < 4; ++j) { x[j] = cv[tl * 256 + lane + 64 * j]; sm += x[j]; }
        const float mean = wave_sum(sm) * (1.f / 256.f); float q2 = 0.f;
#pragma unroll
        for (int j = 0; j < 4; ++j) { const float dd = x[j] - mean; q2 += dd * dd; }
        const float var = wave_sum(q2) * (1.f / 256.f);
        if (lane == 0) { st[tl * 2] = mean; st[tl * 2 + 1] = frsq(var + 1e-5f); } }
    __syncthreads();
    {
#pragma unroll
        for (int tt = 0; tt < 16; ++tt) { const int tl = tg * 16 + tt; As[tl * 264 + c] = f2bf(silu_((cv[tl * 256 + c] - st[tl * 2]) * st[tl * 2 + 1] * lg + lb)); }
    }
    __syncthreads();
    {
        pg8::f32x4 acc[2][2];
#pragma unroll
        for (int rt = 0; rt < 2; ++rt)
#pragma unroll
            for (int cc = 0; cc < 2; ++cc) acc[rt][cc] = (pg8::f32x4){0.f, 0.f, 0.f, 0.f};
#pragma unroll
        for (int ks = 0; ks < 8; ++ks) { pg8::bf16x8 a[2], b[2];
#pragma unroll
            for (int rt = 0; rt < 2; ++rt) a[rt] = *(const pg8::bf16x8*)(As + (16 * rt + fr) * 264 + ks * 32 + fq * 8);
#pragma unroll
            for (int cc = 0; cc < 2; ++cc) b[cc] = bop[ks][cc];
#pragma unroll
            for (int rt = 0; rt < 2; ++rt)
#pragma unroll
                for (int cc = 0; cc < 2; ++cc) acc[rt][cc] = mfma16(a[rt], b[cc], acc[rt][cc]); }
#pragma unroll
        for (int rt = 0; rt < 2; ++rt)
#pragma unroll
            for (int cc = 0; cc < 2; ++cc)
#pragma unroll
                for (int i = 0; i < 4; ++i) Y[(size_t)(m0 + 16 * rt + 4 * fq + i) * D + 512 + 32 * wave + 16 * cc + fr] = f2bf(acc[rt][cc][i]);
    }
}

DEV void pool_item(const Params& P, int l, int it, unsigned char* lds) {
    const int tid = TID(), lane = tid & 63, wave = tid >> 6, fr = lane & 15, fq = lane >> 4;
    const bf16_t* Z = (const bf16_t*)(P.ws + WS_Z);
    bf16_t* Y = (bf16_t*)(P.ws + WS_H);
    float* ext = (float*)lds;
    bf16_t* As = (bf16_t*)(ext + 96 * 64);
    const int tile = it >> 2, gi = it & 3, hw = 1 << gi;
    const int m0 = tile * 64; const SeqInfo s0 = seq_of(m0);
    const int zc = ZB + gi * 64, x = tid >> 3, c8 = (tid & 7) * 8;
    __syncthreads();
    pg8::bf16x8 pb[2][2]; float psc[2];
    { const bf16_t* BT = (const bf16_t*)(P.ws + WS_SW) + (size_t)l * SW_LAYER + SW_POOL + gi * 4096;
#pragma unroll
      for (int cc = 0; cc < 2; ++cc) { const int ct = 2 * (wave & 1) + cc; psc[cc] = INP(I_POOLS)[(size_t)l * DG + gi * 64 + 16 * ct + fr];
#pragma unroll
          for (int ks = 0; ks < 2; ++ks) pb[cc][ks] = *(const pg8::bf16x8*)(BT + (16 * ct + fr) * 64 + ks * 32 + fq * 8); } }
    int nrows = 1;
    if (s0.lat) {
        const int rr = s0.t / 64, r_lo = rr - hw > 0 ? rr - hw : 0, r_hi = rr + hw < GRID_ROWS ? rr + hw : GRID_ROWS; nrows = r_hi - r_lo;
        float a[8];
#pragma unroll
        for (int j = 0; j < 8; ++j) a[j] = 0.f;
#pragma unroll
        for (int rq = 0; rq < 16; ++rq) { const int r2 = rr - hw + rq, r2c = r2 < 0 ? 0 : (r2 >= GRID_ROWS ? GRID_ROWS - 1 : r2); const bool ok = rq < 2 * hw && r2 == r2c;
            const pg8::u32x4 v = *(const pg8::u32x4*)(Z + (size_t)(s0.base + r2c * 64 + x) * ZW + zc + c8);
#pragma unroll
            for (int j = 0; j < 4; ++j) { a[2 * j] += ok ? __builtin_bit_cast(float, v[j] << 16) : 0.f; a[2 * j + 1] += ok ? __builtin_bit_cast(float, v[j] & 0xffff0000u) : 0.f; } }
        *(pg8::f32x4*)(ext + (16 + x) * 64 + c8) = (pg8::f32x4){a[0], a[1], a[2], a[3]}; *(pg8::f32x4*)(ext + (16 + x) * 64 + c8 + 4) = (pg8::f32x4){a[4], a[5], a[6], a[7]};
    } else {
#pragma unroll
        for (int r = 0; r < 2; ++r) { const int e = tid + 512 * r; if (e >= 96 * 8) continue; const int xr = (e >> 3) - 16, cc = (e & 7) * 8, t = s0.t + xr, tc = t < 0 ? 0 : (t >= s0.T ? s0.T - 1 : t); float a[8];
            const pg8::u32x4 v = *(const pg8::u32x4*)(Z + (size_t)(s0.base + tc) * ZW + zc + cc);
#pragma unroll
            for (int j = 0; j < 4; ++j) { a[2 * j] = t == tc ? __builtin_bit_cast(float, v[j] << 16) : 0.f; a[2 * j + 1] = t == tc ? __builtin_bit_cast(float, v[j] & 0xffff0000u) : 0.f; }
            *(pg8::f32x4*)(ext + (e >> 3) * 64 + cc) = (pg8::f32x4){a[0], a[1], a[2], a[3]}; *(pg8::f32x4*)(ext + (e >> 3) * 64 + cc + 4) = (pg8::f32x4){a[4], a[5], a[6], a[7]}; }
    }
    __syncthreads();
    {
        int lo, hi;
        if (s0.lat) { lo = x - hw > 0 ? x - hw : 0; hi = x + hw < 64 ? x + hw : 64; }
        else { const int t = s0.t + x; lo = (t - hw > 0 ? t - hw : 0) - s0.t; hi = (t + hw < s0.T ? t + hw : s0.T) - s0.t; }
        pg8::f32x4 a0 = {0.f, 0.f, 0.f, 0.f}, a1 = {0.f, 0.f, 0.f, 0.f};
        for (int x2 = lo; x2 < hi; ++x2) { a0 = a0 + *(const pg8::f32x4*)(ext + (16 + x2) * 64 + c8); a1 = a1 + *(const pg8::f32x4*)(ext + (16 + x2) * 64 + c8 + 4); }
        const float sc = 1.f / (float)((hi - lo) * nrows);
        const pg8::u32x4 ov = *(const pg8::u32x4*)(Z + (size_t)(m0 + x) * ZW + zc + c8);
        pg8::u32x4 w;
#pragma unroll
        for (int j = 0; j < 4; ++j) { const float p0 = (j < 2 ? a0[2 * j] : a1[2 * j - 4]) * sc - __builtin_bit_cast(float, ov[j] << 16), p1 = (j < 2 ? a0[2 * j + 1] : a1[2 * j - 3]) * sc - __builtin_bit_cast(float, ov[j] & 0xffff0000u); w[j] = pk2(p0, p1); }
        *(pg8::u32x4*)(As + x * LT + c8) = w;
    }
    __syncthreads();
    {
        const int rt = wave >> 1;
#pragma unroll
        for (int cc = 0; cc < 2; ++cc) { const int ct = 2 * (wave & 1) + cc; pg8::f32x4 acc = {0.f, 0.f, 0.f, 0.f};
#pragma unroll
            for (int ks = 0; ks < 2; ++ks) acc = mfma16(*(const pg8::bf16x8*)(As + (16 * rt + fr) * LT + ks * 32 + fq * 8), pb[cc][ks], acc);
            const float sc = psc[cc];
#pragma unroll
            for (int i = 0; i < 4; ++i) Y[(size_t)(m0 + 16 * rt + 4 * fq + i) * D + 256 + gi * 64 + 16 * ct + fr] = f2bf(acc[i] * sc); }
    }
}

constexpr int N_RW_LAT = DEC_BATCH * 8, N_ML_LAT = DEC_BATCH * 8, N_HEAVY = N_RW_LAT + N_ML_LAT;
constexpr int N_RW_CTX = BATCH * 8, N_ML_CTX = BATCH * 8, N_CONV = M / 32, N_POOL = (M / 64) * 4;
DEV void phase_mixers(const Params& P, int l, unsigned char* lds) {
    const int G = gridDim.x, b = blockIdx.x;
    int r0, r1, rs, q0, q1, qs, c0, cs, p0;
    if (G >= 2 * N_HEAVY) {
        const int nb = G - N_HEAVY, bb = b - N_HEAVY;
        if (b < N_RW_LAT) { r0 = b; r1 = b + 1; rs = 1; q0 = 0; q1 = 0; qs = 1; c0 = N_CONV; cs = 1; p0 = N_POOL; }
        else if (b < N_HEAVY) { r0 = 0; r1 = 0; rs = 1; q0 = b - N_RW_LAT; q1 = q0 + 1; qs = 1; c0 = N_CONV; cs = 1; p0 = N_POOL; }
        else { r0 = N_RW_LAT + bb; r1 = N_RW_LAT + N_RW_CTX; rs = nb; q0 = N_ML_LAT + (bb + nb / 2) % nb; q1 = N_ML_LAT + N_ML_CTX; qs = nb; c0 = (bb + nb / 4) % nb; cs = nb; p0 = (bb + 3 * nb / 4) % nb; }
    } else { r0 = b; r1 = N_RW_LAT + N_RW_CTX; rs = G; q0 = b; q1 = N_ML_LAT + N_ML_CTX; qs = G; c0 = b; cs = G; p0 = b; }
    TS_START(26, lds); if (b >= N_HEAVY) TS_START(30, lds);
    for (int r = r0; r < r1; r += rs) {
        rwkv_chunk_scan_item(P, l, r < N_RW_LAT ? BATCH * 8 + r : r - N_RW_LAT, lds); }
    if (b < N_RW_LAT) TS_STOP(26, lds); if (b >= N_HEAVY) TS_STOP(30, lds);
    TS_START(31, lds);
    for (int q = q0; q < q1; q += qs) { const int ch = q < N_ML_LAT ? BATCH * 8 + q : q - N_ML_LAT; mlstm_state_item(P, l, ch, lds); }
    TS_STOP(31, lds); TS_START(28, lds);
    for (int it = c0; it < N_CONV; it += cs) conv_item(P, l, it, lds);
    TS_STOP(28, lds); TS_START(29, lds);
    for (int it = p0; it < N_POOL; it += cs) pool_item(P, l, it, lds);
    TS_STOP(29, lds);
}

DEV void phase_finalize(const Params& P, int l) {
    const int tid = TID(), lane = tid & 63, wave = tid >> 6;
    const int gw = blockIdx.x * 8 + wave, NGW = gridDim.x * 8;
    bf16_t* Y = (bf16_t*)(P.ws + WS_H);
    const f16* RY = (const f16*)(P.ws + WS_RY); const f16* RG = (const f16*)(P.ws + WS_RG);
    const int c0 = 4 * lane;
    float lg[4], lb[4];
#pragma unroll
    for (int j = 0; j < 4; ++j) { lg[j] = INP(I_LNG)[(size_t)l * DG + c0 + j]; lb[j] = INP(I_LNB)[(size_t)l * DG + c0 + j]; }
    for (int m = gw; m < M; m += NGW) {
        {
            const h4 a = *(const h4*)(RY + (size_t)m * DG + c0), b = *(const h4*)(RY + ((size_t)M + m) * DG + c0), g = *(const h4*)(RG + (size_t)m * DG + c0);
            float y[4]; float s = 0.f;
#pragma unroll
            for (int j = 0; j < 4; ++j) { y[j] = (float)a[j] + (float)b[j]; s += y[j]; }
            const float mean = sum16(s) * (1.f / 64.f); float q2 = 0.f;
#pragma unroll
            for (int j = 0; j < 4; ++j) { y[j] -= mean; q2 += y[j] * y[j]; }
            const float rs = frsq(sum16(q2) * (1.f / 64.f) + 64e-5f);
            float o[4];
#pragma unroll
            for (int j = 0; j < 4; ++j) o[j] = (y[j] * rs * lg[j] + lb[j]) * (float)g[j];
            *(unsigned long long*)(Y + (size_t)m * D + c0) = (unsigned long long)pk2(o[0], o[1]) | ((unsigned long long)pk2(o[2], o[3]) << 32);
        }
    }
}

constexpr int PH_PER_LAYER = 9, NPHASES = 2 + PH_PER_LAYER * DEPTH;
DEV void run_phase(const Params& P, int ph, unsigned char* lds) {
#ifndef PH_MASK
#define PH_MASK 0xFFFF
#endif
    if (ph == 0) { if (PH_MASK & 0x200) phase_prologue(P, lds); return; }
    if (ph == NPHASES - 1) { if (PH_MASK & 0x400) phase_final(P); return; }
    const int l = (ph - 1) / PH_PER_LAYER, k = (ph - 1) % PH_PER_LAYER;
    const int G = gridDim.x, b = blockIdx.x;
    bool is_gemm = false; pg8::Gemm g{nullptr, nullptr, M, 0, 0}; pg8::EpiAny E{};
    switch (k) {
    case 0: if (!(PH_MASK & (1 << 0))) break; phase_norm(P, l, 0); break;
    case 1: g = pg8::Gemm{(const bf16_t*)(P.ws + WS_H), (const bf16_t*)(P.ws + WS_WIN) + (size_t)l * ZW * D, M, ZW, D};
            E.mode = 0; E.perm = true; E.b0 = pg8::EpiBf16<0>{(bf16_t*)(P.ws + WS_Z), ZW, nullptr}; is_gemm = true; break;
    case 2: TS_START(24, lds); phase_rwkv_prep(P, l, lds); TS_STOP(24, lds); TS_START(25, lds); for (int it = (b + G / 2) % G; it < NTC * 4; it += G) mlstm_local_item(P, l, it, lds); TS_STOP(25, lds); break;
    case 3: phase_mixers(P, l, lds); break;
    case 4: TS_START(20, lds); for (int it = b; it < NTC * 4; it += G) mlstm_out_item(P, l, it, lds); TS_STOP(20, lds); TS_START(21, lds); phase_finalize(P, l); TS_STOP(21, lds); break;
    case 5: g = pg8::Gemm{(const bf16_t*)(P.ws + WS_H), (const bf16_t*)(P.ws + WS_WOUT) + (size_t)l * D * D, M, D, D};
            E.mode = 2; E.perm = false; E.rs = pg8::EpiRes{l == 0 ? INP(I_XP) : P.out, l == 0 ? INP(I_XS) : P.out + (size_t)M_CTX * D, P.out, mod_vec(P, l, 0) + 2048, nullptr}; is_gemm = true; break;
    case 6: phase_norm(P, l, 1); break;
    case 7: g = pg8::Gemm{(const bf16_t*)(P.ws + WS_H), (const bf16_t*)(P.ws + WS_W1) + (size_t)l * DFF * D, M, DFF, D};
            E.mode = 1; E.perm = true; E.b1 = pg8::EpiBf16<1>{(bf16_t*)(P.ws + WS_OV), DFF, INP(I_B1) + (size_t)l * DFF}; is_gemm = true; break;
    case 8: g = pg8::Gemm{(const bf16_t*)(P.ws + WS_OV), (const bf16_t*)(P.ws + WS_W2) + (size_t)l * D * DFF, M, D, DFF};
            E.mode = 2; E.perm = false; E.rs = pg8::EpiRes{P.out, P.out + (size_t)M_CTX * D, P.out, mod_vec(P, l, 0) + 5120, INP(I_B2) + (size_t)l * D}; is_gemm = true; break;
    }
    if (is_gemm) { pg8::StaticOrder S; S.init(M, g.N, G, b); pg8::gemm_phase<pg8::EpiAny, pg8::StaticOrder, true, true>(LDSP(lds), g, S, E); }
}

#ifndef CPU_EMU
namespace cg = cooperative_groups;
#define LAS __attribute__((address_space(3)))
#define XB_TMO      128
#define XB_XCNT(j)  (256  + 64 * (j))
#define XB_XSUB(j)  (1280 + 64 * (j))
#define XB_XGEN(j)  (2304 + 64 * (j))
#define XB_TOP      3328
#define XB_TOPGEN   3392
#define XCD_BAR_WORDS 3456
#define XB_SPIN_CAP (1u << 22)
__device__ __forceinline__ unsigned xb_ld(unsigned* p)              { return __hip_atomic_load(p, __ATOMIC_RELAXED, __HIP_MEMORY_SCOPE_AGENT); }
__device__ __forceinline__ unsigned xb_add(unsigned* p, unsigned v) { return __hip_atomic_fetch_add(p, v, __ATOMIC_RELAXED, __HIP_MEMORY_SCOPE_AGENT); }
__device__ __forceinline__ unsigned xb_xcc_id() { return (unsigned)__builtin_amdgcn_s_getreg((3 << 11) | 20) & 0xFu; }
#define XB_SPIN(cond, bar) do { unsigned _sp = 0; while (cond) { __builtin_amdgcn_s_sleep(1); \
    if ((++_sp & 255u) == 0u) { if (xb_ld(&(bar)[XB_TMO])) break; if (_sp > XB_SPIN_CAP) { atomicAdd(&(bar)[XB_TMO], 1u); break; } } } } while (0)
struct XcdBarrier { unsigned* bar; unsigned x; volatile LAS unsigned* st; };
__device__ __forceinline__ XcdBarrier xcd_barrier_post(unsigned* bar, volatile LAS unsigned* st) {
    XcdBarrier b; b.bar = bar; b.x = xb_xcc_id(); b.st = st;
    if (threadIdx.x == 0) (void)xb_add(&bar[XB_XCNT(b.x)], 1u);
    return b;
}
__device__ __forceinline__ void xcd_barrier_complete(unsigned* bar, unsigned x, unsigned& nloc, unsigned& nx) {
    const unsigned G = gridDim.x * gridDim.y * gridDim.z;
    unsigned sum, cnt, mine, sp = 0u;
    for (;;) {
        sum = 0u; cnt = 0u; mine = 0u;
#pragma unroll
        for (unsigned j = 0; j < 16; ++j) { const unsigned c = xb_ld(&bar[XB_XCNT(j)]); sum += c; cnt += (c > 0u) ? 1u : 0u; mine = (j == x) ? c : mine; }
        if (sum == G) break;
        __builtin_amdgcn_s_sleep(1);
        if ((++sp & 255u) == 0u) { if (xb_ld(&bar[XB_TMO])) break; if (sp > XB_SPIN_CAP) { atomicAdd(&bar[XB_TMO], 1u); break; } }
    }
    nloc = mine > 0u ? mine : 1u; nx = cnt > 0u ? cnt : 1u;
}
__device__ __forceinline__ void xcd_barrier(const XcdBarrier& b) {
    asm volatile("s_waitcnt vmcnt(0)" ::: "memory");
    __syncthreads();
    if (threadIdx.x == 0) {
        unsigned* bar = b.bar;
        __builtin_amdgcn_s_waitcnt(0);
        unsigned nloc = b.st[0], nx = b.st[1];
        if (nloc == 0u) { xcd_barrier_complete(bar, b.x, nloc, nx); b.st[0] = nloc; b.st[1] = nx; }
        const unsigned old = xb_add(&bar[XB_XSUB(b.x)], 1u);
        const unsigned gen = old / nloc;
        if (old + 1u == (gen + 1u) * nloc) {
            __builtin_amdgcn_fence(__ATOMIC_RELEASE, "agent");
            asm volatile("s_waitcnt vmcnt(0)" ::: "memory");
            const unsigned og = xb_add(&bar[XB_TOP], 1u);
            const unsigned tg = og / nx;
            if (og + 1u == (tg + 1u) * nx) xb_add(&bar[XB_TOPGEN], 1u);
            else XB_SPIN(xb_ld(&bar[XB_TOPGEN]) == tg, bar);
            __builtin_amdgcn_fence(__ATOMIC_ACQUIRE, "agent");
            xb_add(&bar[XB_XGEN(b.x)], 1u);
            asm volatile("s_waitcnt vmcnt(0)" ::: "memory");
        } else {
            XB_SPIN(xb_ld(&bar[XB_XGEN(b.x)]) == gen, bar);
            __builtin_amdgcn_fence(__ATOMIC_ACQUIRE, "agent");
            asm volatile("s_waitcnt vmcnt(0)" ::: "memory");
        }
    }
    __syncthreads();
}

constexpr int MISC_OFF = 131072 + 320;
constexpr size_t CTL_ZERO = 65536;
__global__ void __launch_bounds__(512, 2) mega_fwd(Params P, int ph_lo, int ph_hi) {
    extern __shared__ __attribute__((aligned(16))) unsigned char lds[];
    cg::grid_group grid = cg::this_grid();
    volatile LAS unsigned* misc = (volatile LAS unsigned*)((LAS unsigned char*)lds + MISC_OFF);
    if (threadIdx.x < 32) misc[threadIdx.x] = 0u;
    __syncthreads();
    XcdBarrier bar = xcd_barrier_post((unsigned*)(P.ws + WS_CTL) + 1024, misc + 8);
#ifdef PROBE_TS
    const int ph_end = ph_hi + 1;
#else
    const int ph_end = ph_hi;
#endif
    for (int ph = ph_lo; ph < ph_end; ++ph) {
#ifdef PROBE_TS
        if (threadIdx.x == 0) misc[16] = (unsigned)__builtin_amdgcn_s_memrealtime();
        if (ph < ph_hi)
#endif
        run_phase(P, ph, lds);
#ifdef PROBE_TS
        if (threadIdx.x == 0 && ph < ph_hi) { const unsigned t_ = (unsigned)__builtin_amdgcn_s_memrealtime();
            if ((ph == 0 ? 9 : (ph == NPHASES - 1 ? 10 : (ph - 1) % PH_PER_LAYER)) == PROBE_TS) misc[17] = misc[17] + (t_ - misc[16]);
            misc[16] = t_;
            if (ph == ph_hi - 1 && PROBE_TS != 11) atomicMax((unsigned*)(P.ws + WS_CTL) + 8192, (unsigned)misc[17]); }
#endif
        if (ph + 1 < ph_end) { if (P.ws == nullptr) grid.sync(); else xcd_barrier(bar); }
#ifdef PROBE_TS
        if (PROBE_TS == 11 && threadIdx.x == 0 && ph + 1 < ph_hi) { misc[17] = misc[17] + ((unsigned)__builtin_amdgcn_s_memrealtime() - misc[16]);
            if (ph == ph_hi - 2) atomicMax((unsigned*)(P.ws + WS_CTL) + 8192, (unsigned)misc[17]); }
#endif
    }
#ifdef PROBE_TS
    if (blockIdx.x == 0 && threadIdx.x == 0) {
        const unsigned v = __hip_atomic_load((unsigned*)(P.ws + WS_CTL) + 8192, __ATOMIC_RELAXED, __HIP_MEMORY_SCOPE_AGENT);
        const unsigned long long tend = __builtin_amdgcn_s_memrealtime() + (unsigned long long)v * PROBE_K;
        while (__builtin_amdgcn_s_memrealtime() < tend) __builtin_amdgcn_s_sleep(8);
    }
#endif
}

extern "C" void kernel_launch(void* const* d_in, const int* in_sizes, int n_in, void* d_out, int out_size, void* d_ws, size_t ws_size, hipStream_t stream) {
    static int grid = 0;
    if (grid == 0) {
        if (n_in != N_IN || ws_size < WS_END) { fprintf(stderr, "kernel_launch: unexpected n_in %d or ws_size %zu (need %zu)\n", n_in, ws_size, (size_t)WS_END); grid = -1; return; }
        int dev = 0, cus = 0, per_cu = 0;
        (void)hipGetDevice(&dev); (void)hipDeviceGetAttribute(&cus, hipDeviceAttributeMultiprocessorCount, dev);
        (void)hipFuncSetAttribute((const void*)mega_fwd, hipFuncAttributeMaxDynamicSharedMemorySize, LDS_BYTES);
        (void)hipOccupancyMaxActiveBlocksPerMultiprocessor(&per_cu, (const void*)mega_fwd, 512, LDS_BYTES);
        if (per_cu < 1) { fprintf(stderr, "kernel_launch: occupancy query says %d blocks per CU\n", per_cu); per_cu = 1; }
        grid = cus * 1;
    }
    if (grid < 0) return;
    (void)hipMemsetAsync((char*)d_ws + WS_CTL, 0, CTL_ZERO, stream);
    Params p{};
    for (int i = 0; i < N_IN; ++i) p.in[i] = (const float*)d_in[i];
    p.out = (float*)d_out; p.ws = (unsigned char*)d_ws;
    int lo = 0, hi = NPHASES;
    void* args[] = {&p, &lo, &hi};
    hipError_t e = hipLaunchCooperativeKernel((const void*)mega_fwd, dim3(grid), dim3(512), args, LDS_BYTES, stream);
    if (e != hipSuccess) fprintf(stderr, "cooperative launch failed: %s (grid %d)\n", hipGetErrorString(e), grid);
}
#endif
```
